# Optimizing an MI355X kernel written in HIP

```python
import jax
import jax.numpy as jnp
from jax import lax
import numpy as np

D_MODEL = 1024
BATCH = 2
SEQ = 16384
DEPTH = 4
DEC_BATCH = 16
DEC_SEQ = 2048
PAST_LEN = 128

PLE_DIM = 256
HEAD_DIM = 64
RMS_EPS = 1e-6
RWKV_HEADS = 8
RWKV_W = RWKV_HEADS * HEAD_DIM
DECAY_LORA = 64
ICLR_LORA = 64
GATE_LORA = 128
RWKV_IN = 3 * RWKV_W + 2 * DECAY_LORA + 2 * ICLR_LORA + GATE_LORA
GN_EPS = 64e-5
ATTN_PATTERNS = ((128, 1), (512, 4), (2048, 16))
ATTN_HEADS_PER_GROUP = 4
ATTN_HEADS = ATTN_HEADS_PER_GROUP * len(ATTN_PATTERNS)
ATTN_IN = 3 * ATTN_HEADS * HEAD_DIM
ATTN_OUT = ATTN_HEADS_PER_GROUP * HEAD_DIM
ROPE_THETA = 500000.0
ROT_DIM = HEAD_DIM // 4
NEG_INF = -1e30
AB_IN = RWKV_IN + ATTN_IN
AB_OUT = RWKV_W + ATTN_OUT
POOL_WINDOWS = (2, 4, 8, 16)
POOL_GROUP = 256
POOL_W = len(POOL_WINDOWS) * POOL_GROUP
D_FF = 2816
CONV_WIDTH = 3
N_EVEN = (DEPTH + 1) // 2
N_ODD = DEPTH // 2

kernel_name = 'hybrid_rwkv7_dilattn_pool_encoder'


def _rmsnorm(x, g):
    xf = x.astype(jnp.float32)
    y = xf * lax.rsqrt(jnp.mean(xf * xf, axis=-1, keepdims=True) + RMS_EPS)
    return (y * g.astype(jnp.float32)).astype(x.dtype)


def _centred_shift(z):
    zp = jnp.pad(z, ((0, 0), (1, 1), (0, 0)))
    return 0.5 * (zp[:, :-2] + zp[:, 2:])


def _partial_rotary(t, pos):
    half = ROT_DIM // 2
    inv = jnp.float32(ROPE_THETA) ** (-jnp.arange(half, dtype=jnp.float32) * 2.0 / ROT_DIM)
    ang = pos[:, None] * inv[None, :]
    cos = jnp.cos(ang)[None, :, None, :]
    sin = jnp.sin(ang)[None, :, None, :]
    tf = t.astype(jnp.float32)
    x1 = tf[..., :half]
    x2 = tf[..., half:ROT_DIM]
    return jnp.concatenate([x1 * cos - x2 * sin, x2 * cos + x1 * sin, tf[..., ROT_DIM:]], axis=-1)


def _band_attention(q, k, v, half):
    n, L, hd = q.shape
    qb = half
    nb = -(-L // qb)
    lp = nb * qb
    qf = jnp.pad(q.astype(jnp.float32), ((0, 0), (0, lp - L), (0, 0))).reshape(n, nb, qb, hd)

    def key_windows(t):
        tp = jnp.pad(t.astype(jnp.float32), ((0, 0), (qb, lp - L + qb), (0, 0))).reshape(n, nb + 2, qb, hd)
        return jnp.concatenate([tp[:, :-2], tp[:, 1:-1], tp[:, 2:]], axis=2)

    kw = key_windows(k)
    vw = key_windows(v)
    s = jnp.einsum('nbqd,nbkd->nbqk', qf, kw) * (hd ** -0.5)
    qi = jnp.arange(qb)[:, None]
    kc = jnp.arange(3 * qb)[None, :]
    rel = kc - qb - qi
    kpos = jnp.arange(nb)[:, None, None] * qb + kc[None] - qb
    valid = (jnp.abs(rel) <= half)[None] & (kpos >= 0) & (kpos < L)
    s = jnp.where(valid[None], s, NEG_INF)
    m = jnp.max(s, axis=-1, keepdims=True)
    pexp = jnp.exp(s - m)
    den = jnp.sum(pexp, axis=-1, keepdims=True)
    o = jnp.einsum('nbqk,nbkd->nbqd', pexp, vw) / den
    lse = (m + jnp.log(den))[..., 0]
    return o.reshape(n, lp, hd)[:, :L], lse.reshape(n, lp)[:, :L]


def _dilated_attention(q, k, v, dil, half):
    b, s, h, hd = q.shape
    L = s // dil

    def to_sub(t):
        return t.reshape(b, L, dil, h, hd).transpose(0, 2, 3, 1, 4).reshape(b * dil * h, L, hd)

    o, lse = _band_attention(to_sub(q), to_sub(k), to_sub(v), half)
    o = o.reshape(b, dil, h, L, hd).transpose(0, 3, 1, 2, 4).reshape(b, s, h, hd)
    lse = lse.reshape(b, dil, h, L).transpose(0, 3, 1, 2).reshape(b, s, h)
    return o, lse


def _dilated_mixture_attention(z):
    b, s, _ = z.shape
    q, k, v = jnp.split(z, 3, axis=-1)
    shp = (b, s, ATTN_HEADS, HEAD_DIM)
    pos = jnp.arange(s, dtype=jnp.float32)
    q = _partial_rotary(q.reshape(shp), pos)
    k = _partial_rotary(k.reshape(shp), pos)
    v = v.reshape(shp)
    outs, lses = [], []
    for g, (win, dil) in enumerate(ATTN_PATTERNS):
        hs = slice(g * ATTN_HEADS_PER_GROUP, (g + 1) * ATTN_HEADS_PER_GROUP)
        o, lse = _dilated_attention(q[:, :, hs], k[:, :, hs], v[:, :, hs], dil, win // (2 * dil))
        outs.append(o)
        lses.append(lse)
    alpha = jax.nn.softmax(jnp.stack(lses), axis=0)[..., None]
    y = jnp.sum(alpha * jnp.stack(outs), axis=0)
    return y.reshape(b, s, ATTN_OUT)


def _wkv_scan(decay, kk, kka, k, v, r, reverse):
    b, s, h, n = r.shape
    xs = tuple(jnp.moveaxis(t, 1, 0) for t in (decay, kk, kka, k, v, r))

    def step(state, inp):
        w_t, kk_t, kka_t, k_t, v_t, r_t = inp
        sa = jnp.einsum('bhvk,bhk->bhv', state, kk_t)
        state = (state * w_t[:, :, None, :] - sa[..., None] * kka_t[:, :, None, :]
                 + v_t[..., None] * k_t[:, :, None, :])
        return state, jnp.einsum('bhvk,bhk->bhv', state, r_t)

    s0 = jnp.zeros((b, h, n, n), jnp.float32)
    _, y = lax.scan(step, s0, xs, reverse=reverse)
    return jnp.moveaxis(y, 0, 1)


def _rwkv7_bidir(z, mu, w0, w_up, a0, a_up, g_up, k_k, k_a, r_k, ln_g, ln_b):
    b, s, _ = z.shape
    z = (z + mu * (_centred_shift(z) - z)).astype(jnp.float32)
    r = z[..., :RWKV_W]
    k = z[..., RWKV_W:2 * RWKV_W]
    v = z[..., 2 * RWKV_W:3 * RWKV_W]
    o = 3 * RWKV_W
    wd = z[..., o:o + 2 * DECAY_LORA].reshape(b, s, 2, DECAY_LORA)
    o += 2 * DECAY_LORA
    ad = z[..., o:o + 2 * ICLR_LORA].reshape(b, s, 2, ICLR_LORA)
    o += 2 * ICLR_LORA
    gd = z[..., o:]
    w_log = w0 + jnp.einsum('bsdl,dlc->bsdc', jnp.tanh(wd), w_up)
    decay = jnp.exp(-jnp.exp(-jax.nn.softplus(-w_log) - 0.5))
    a = jax.nn.sigmoid(a0 + jnp.einsum('bsdl,dlc->bsdc', ad, a_up))
    g = jax.nn.sigmoid(gd) @ g_up

    def heads(t):
        return t.reshape(t.shape[:-1] + (RWKV_HEADS, HEAD_DIM))

    kk = heads(k * k_k)
    kk = kk / jnp.sqrt(jnp.sum(kk * kk, axis=-1, keepdims=True) + 1e-12)
    kdir = heads(k[:, :, None, :] * (1.0 + (a - 1.0) * k_a))
    adir = heads(a)
    dec = heads(decay)
    rh = heads(r)
    vh = heads(v)
    y = (_wkv_scan(dec[:, :, 0], kk, kk * adir[:, :, 0], kdir[:, :, 0], vh, rh, False)
         + _wkv_scan(dec[:, :, 1], kk, kk * adir[:, :, 1], kdir[:, :, 1], vh, rh, True))
    mean = jnp.mean(y, axis=-1, keepdims=True)
    var = jnp.mean((y - mean) ** 2, axis=-1, keepdims=True)
    yn = ((y - mean) * lax.rsqrt(var + GN_EPS)).reshape(b, s, RWKV_W) * ln_g + ln_b
    bonus = jnp.sum(rh * (kdir[:, :, 0] + kdir[:, :, 1]) * r_k, axis=-1, keepdims=True) * vh
    return (yn + bonus.reshape(b, s, RWKV_W)) * g


def _mixer_ab(h, prm, j):
    z = h @ prm['ab_w_in'][j]
    ya = _rwkv7_bidir(z[..., :RWKV_IN], prm['rwkv_mu'][j], prm['rwkv_w0'][j], prm['rwkv_w_up'][j],
                      prm['rwkv_a0'][j], prm['rwkv_a_up'][j], prm['rwkv_g_up'][j], prm['rwkv_k_k'][j],
                      prm['rwkv_k_a'][j], prm['rwkv_r_k'][j], prm['rwkv_ln_g'][j], prm['rwkv_ln_b'][j])
    yb = _dilated_mixture_attention(z[..., RWKV_IN:])
    y = jnp.concatenate([ya.astype(h.dtype), yb.astype(h.dtype)], axis=-1)
    return y @ prm['ab_w_out'][j]


def _pool_mixer(h, w_in, w_group, scale, w_out):
    u = (h @ w_in).astype(jnp.float32)
    b, s, _ = u.shape
    cs = jnp.concatenate([jnp.zeros((b, 1, POOL_W), jnp.float32), jnp.cumsum(u, axis=1)], axis=1)
    t = jnp.arange(s)
    ys = []
    for g, win in enumerate(POOL_WINDOWS):
        rad = win // 2
        lo = jnp.clip(t - rad, 0, s)
        hi = jnp.clip(t + rad + 1, 0, s)
        cols = slice(g * POOL_GROUP, (g + 1) * POOL_GROUP)
        csg = cs[..., cols]
        mean = (jnp.take(csg, hi, axis=1) - jnp.take(csg, lo, axis=1)) / (hi - lo).astype(jnp.float32)[None, :, None]
        ys.append((mean - u[..., cols]) @ w_group[g])
    y = jnp.concatenate(ys, axis=-1) * scale
    return y.astype(h.dtype) @ w_out


def _conv_ffn(h, w_up, conv_w, conv_b, w_down):
    u = h @ w_up
    up = jnp.pad(u, ((0, 0), (1, 1), (0, 0)))
    c = up[:, :-2] * conv_w[0] + up[:, 1:-1] * conv_w[1] + up[:, 2:] * conv_w[2] + conv_b
    gate, val = jnp.split(c, 2, axis=-1)
    return (jax.nn.gelu(gate) * val) @ w_down


def _ple(h, p_i, w_proj, w_gate, b_gate):
    return jax.nn.sigmoid(h @ w_gate + b_gate) * (p_i @ w_proj)


def _trunk(x, p, prm):
    for i in range(DEPTH):
        j = i // 2
        h = _rmsnorm(x, prm['norm_mix_g'][i])
        if i % 2 == 0:
            y = _mixer_ab(h, prm, j)
        else:
            y = _pool_mixer(h, prm['c_w_in'][j], prm['c_w_group'][j], prm['c_scale'][j], prm['c_w_out'][j])
        x = x + y.astype(x.dtype)
        x = x + _conv_ffn(_rmsnorm(x, prm['norm_ffn_g'][i]), prm['ffn_w_up'][i], prm['ffn_conv_w'][i],
                          prm['ffn_conv_b'][i], prm['ffn_w_down'][i]).astype(x.dtype)
        x = x + _ple(_rmsnorm(x, prm['norm_ple_g'][i]), p[i], prm['ple_w_proj'][i],
                     prm['ple_w_gate'][i], prm['ple_b_gate'][i]).astype(x.dtype)
    return _rmsnorm(x, prm['norm_final_g'])


def setup_inputs(seed: int = 0) -> dict:
    key = jax.random.key(seed)
    ks = iter(jax.random.split(key, 40))
    f32 = jnp.float32

    def nrm(shape, scale):
        return scale * jax.random.normal(next(ks), shape, f32)

    def uni(shape, lo, hi):
        return jax.random.uniform(next(ks), shape, f32, lo, hi)

    return {
        'x_prompt': nrm((BATCH, SEQ, D_MODEL), 1.0),
        'x_sample': nrm((DEC_BATCH, DEC_SEQ, D_MODEL), 1.0),
        'p_prompt': nrm((DEPTH, BATCH, SEQ, PLE_DIM), 1.0),
        'p_sample': nrm((DEPTH, DEC_BATCH, DEC_SEQ, PLE_DIM), 1.0),
        'ab_w_in': nrm((N_EVEN, D_MODEL, AB_IN), D_MODEL ** -0.5),
        'ab_w_out': nrm((N_EVEN, AB_OUT, D_MODEL), AB_OUT ** -0.5),
        'rwkv_mu': uni((N_EVEN, RWKV_IN), 0.0, 1.0),
        'rwkv_w0': uni((N_EVEN, 2, RWKV_W), -6.0, -1.0),
        'rwkv_w_up': nrm((N_EVEN, 2, DECAY_LORA, RWKV_W), 0.1 * DECAY_LORA ** -0.5),
        'rwkv_a0': nrm((N_EVEN, 2, RWKV_W), 0.1),
        'rwkv_a_up': nrm((N_EVEN, 2, ICLR_LORA, RWKV_W), 0.5 * ICLR_LORA ** -0.5),
        'rwkv_g_up': nrm((N_EVEN, GATE_LORA, RWKV_W), GATE_LORA ** -0.5),
        'rwkv_k_k': 0.85 + nrm((N_EVEN, RWKV_W), 0.05),
        'rwkv_k_a': 1.0 + nrm((N_EVEN, RWKV_W), 0.05),
        'rwkv_r_k': nrm((N_EVEN, RWKV_HEADS, HEAD_DIM), 0.1),
        'rwkv_ln_g': 1.0 + nrm((N_EVEN, RWKV_W), 0.02),
        'rwkv_ln_b': nrm((N_EVEN, RWKV_W), 0.02),
        'c_w_in': nrm((N_ODD, D_MODEL, POOL_W), D_MODEL ** -0.5),
        'c_w_group': nrm((N_ODD, len(POOL_WINDOWS), POOL_GROUP, POOL_GROUP), POOL_GROUP ** -0.5),
        'c_scale': 1.0 + nrm((N_ODD, POOL_W), 0.02),
        'c_w_out': nrm((N_ODD, POOL_W, D_MODEL), POOL_W ** -0.5),
        'norm_mix_g': 1.0 + nrm((DEPTH, D_MODEL), 0.02),
        'norm_ffn_g': 1.0 + nrm((DEPTH, D_MODEL), 0.02),
        'norm_ple_g': 1.0 + nrm((DEPTH, D_MODEL), 0.02),
        'norm_final_g': 1.0 + nrm((D_MODEL,), 0.02),
        'ffn_w_up': nrm((DEPTH, D_MODEL, 2 * D_FF), D_MODEL ** -0.5),
        'ffn_conv_w': nrm((DEPTH, CONV_WIDTH, 2 * D_FF), CONV_WIDTH ** -0.5),
        'ffn_conv_b': nrm((DEPTH, 2 * D_FF), 0.02),
        'ffn_w_down': nrm((DEPTH, D_FF, D_MODEL), D_FF ** -0.5),
        'ple_w_proj': nrm((DEPTH, PLE_DIM, D_MODEL), PLE_DIM ** -0.5),
        'ple_w_gate': nrm((DEPTH, D_MODEL, D_MODEL), D_MODEL ** -0.5),
        'ple_b_gate': nrm((DEPTH, D_MODEL), 0.02),
    }


def reference(x_prompt, x_sample, p_prompt, p_sample, ab_w_in, ab_w_out, rwkv_mu, rwkv_w0, rwkv_w_up,
              rwkv_a0, rwkv_a_up, rwkv_g_up, rwkv_k_k, rwkv_k_a, rwkv_r_k, rwkv_ln_g, rwkv_ln_b,
              c_w_in, c_w_group, c_scale, c_w_out, norm_mix_g, norm_ffn_g, norm_ple_g, norm_final_g,
              ffn_w_up, ffn_conv_w, ffn_conv_b, ffn_w_down, ple_w_proj, ple_w_gate, ple_b_gate):
    prm = {
        'ab_w_in': ab_w_in, 'ab_w_out': ab_w_out, 'rwkv_mu': rwkv_mu, 'rwkv_w0': rwkv_w0,
        'rwkv_w_up': rwkv_w_up, 'rwkv_a0': rwkv_a0, 'rwkv_a_up': rwkv_a_up, 'rwkv_g_up': rwkv_g_up,
        'rwkv_k_k': rwkv_k_k, 'rwkv_k_a': rwkv_k_a, 'rwkv_r_k': rwkv_r_k, 'rwkv_ln_g': rwkv_ln_g,
        'rwkv_ln_b': rwkv_ln_b, 'c_w_in': c_w_in, 'c_w_group': c_w_group, 'c_scale': c_scale,
        'c_w_out': c_w_out, 'norm_mix_g': norm_mix_g, 'norm_ffn_g': norm_ffn_g, 'norm_ple_g': norm_ple_g,
        'norm_final_g': norm_final_g, 'ffn_w_up': ffn_w_up, 'ffn_conv_w': ffn_conv_w,
        'ffn_conv_b': ffn_conv_b, 'ffn_w_down': ffn_w_down, 'ple_w_proj': ple_w_proj,
        'ple_w_gate': ple_w_gate, 'ple_b_gate': ple_b_gate,
    }
    y_prompt = _trunk(x_prompt, p_prompt, prm)
    y_sample = _trunk(x_sample, p_sample, prm)
    return (y_prompt, y_sample)
```

```cpp
#include <hip/hip_runtime.h>
#include <hip/hip_cooperative_groups.h>
#include <cstdio>
namespace cg = cooperative_groups;

typedef unsigned short bf16_t;
typedef short bf16x8 __attribute__((ext_vector_type(8)));
typedef float f32x4 __attribute__((ext_vector_type(4)));

constexpr int DM = 1024, DEPTH = 4, PLE = 256;
constexpr int RW = 512, RWKV_IN = 1920, ATT_IN = 2304, AB_IN = 4224, AB_OUT = 768;
constexpr int DFF = 2816, UP = 5632;
constexpr int TG = 32768;
constexpr int NLORA = 2560, KLORA = 384;
constexpr int CHUNK_L = 512;
constexpr int TB = 8;

constexpr size_t W_AB = (size_t)AB_IN * DM, W_ABO = (size_t)DM * AB_OUT, W_LORA = (size_t)NLORA * KLORA;
constexpr size_t W_EVEN = W_AB + W_ABO + W_LORA;
constexpr size_t W_CIN = (size_t)DM * DM, W_GRP = (size_t)DM * 256, W_COUT = (size_t)DM * DM;
constexpr size_t W_ODD = W_CIN + W_GRP + W_COUT;
constexpr size_t W_UP = (size_t)UP * DM, W_DOWN = (size_t)DM * DFF, W_GATE = (size_t)DM * DM, W_PROJ = (size_t)DM * PLE;
constexpr size_t W_LAYER = W_UP + W_DOWN + W_GATE + W_PROJ;
constexpr size_t WOFF_EVEN = 0, WOFF_ODD = 2 * W_EVEN, WOFF_LAYER = WOFF_ODD + 2 * W_ODD;
constexpr size_t W_TOTAL = WOFF_LAYER + 4 * W_LAYER;

constexpr size_t al256(size_t x) { return (x + 255) / 256 * 256; }
constexpr size_t OFF_W = 0;
constexpr size_t OFF_A = al256(W_TOTAL * 2);
constexpr size_t SZ_A = (size_t)TG * DM * 2;
constexpr size_t OFF_Z1 = OFF_A + SZ_A;
constexpr size_t SZ_Z1 = (size_t)TG * RWKV_IN * 2;
constexpr size_t OFF_Z2 = OFF_Z1 + SZ_Z1;
constexpr size_t SZ_Z2 = (size_t)TG * ATT_IN * 2;
constexpr size_t OFF_Y = OFF_Z2 + SZ_Z2;
constexpr size_t SZ_Y = (size_t)TG * AB_OUT * 2;
constexpr size_t OFF_RKV = OFF_Y + SZ_Y;
constexpr size_t SZ_RKV = (size_t)TG * 1536 * 2;
constexpr size_t OFF_ROT = OFF_RKV + SZ_RKV;
constexpr size_t SZ_ROT = (size_t)16384 * 8 * 8;
constexpr size_t OFF_LSE = OFF_ROT + SZ_ROT;
constexpr size_t SZ_LSE = (size_t)3 * TG * 4 * 4;
constexpr size_t WS_NEED = OFF_LSE + SZ_LSE;
constexpr size_t OFF_L = OFF_A;
constexpr size_t OFF_G = OFF_A + al256((size_t)TG * KLORA * 2);
constexpr size_t OFF_YP = OFF_Z1;
constexpr size_t OFF_SQ = OFF_Z1 + (size_t)2 * TG * RW * 2;
constexpr size_t OFF_SM = OFF_SQ + (size_t)1024 * 4096 * 4;
constexpr size_t OFF_SI = OFF_SM + (size_t)1024 * 4096 * 4;
static_assert(OFF_SI + (size_t)1024 * 4096 * 4 <= OFF_Z2, "scan states overflow Z1");
static_assert((size_t)TG * KLORA * 2 + (size_t)TG * RW * 2 + 256 <= SZ_A, "L+g overflow A");
static_assert((size_t)3 * TG * 256 * 4 <= SZ_RKV, "o_part overflow");

struct Params { const float* in[32]; float* out; char* ws; };

__device__ __forceinline__ bf16_t f2bf(float f) {
  unsigned u = __float_as_uint(f);
  u += 0x7fffu + ((u >> 16) & 1u);
  return (bf16_t)(u >> 16);
}
__device__ __forceinline__ float bf2f(bf16_t h) { return __uint_as_float(((unsigned)h) << 16); }
__device__ __forceinline__ unsigned pack2(float a, float b) { return (unsigned)f2bf(a) | ((unsigned)f2bf(b) << 16); }
__device__ __forceinline__ float lo2f(unsigned u) { return __uint_as_float(u << 16); }
__device__ __forceinline__ float hi2f(unsigned u) { return __uint_as_float(u & 0xffff0000u); }
__device__ __forceinline__ int tid_opaque() { int t = threadIdx.x; asm volatile("" : "+v"(t)); return t; }
__device__ __forceinline__ float wave_sum(float v) {
#pragma unroll
  for (int o = 32; o > 0; o >>= 1) v += __shfl_xor(v, o, 64);
  return v;
}
__device__ __forceinline__ float sigmoidf_(float x) { return 1.0f / (1.0f + __expf(-x)); }
__device__ __forceinline__ float tanhf_(float x) {
  float ax = fabsf(x);
  float e = __expf(-2.0f * ax);
  float t = (1.0f - e) / (1.0f + e);
  return x < 0.f ? -t : t;
}
__device__ __forceinline__ float gelu_tanh(float x) {
  float y = 0.7978845608028654f * (x + 0.044715f * x * x * x);
  return 0.5f * x * (1.0f + tanhf_(y));
}

__device__ __forceinline__ int tile_remap(int t, int ntiles) {
  int G = gridDim.x;
  int it = t / G;
  if ((G & 7) == 0 && (it + 1) * G <= ntiles) {
    int b = t - it * G;
    return it * G + (b & 7) * (G >> 3) + (b >> 3);
  }
  return t;
}

__device__ void transpose_w(const float* __restrict__ src, int K, int N, bf16_t* __restrict__ dst, int ldk, int mode, char* smem) {
  float* tile = (float*)smem;
  const int tid = tid_opaque();
  const int tk = K / 64, tn = N / 64;
  for (int t = blockIdx.x; t < tk * tn; t += gridDim.x) {
    int k0 = (t / tn) * 64, n0 = (t % tn) * 64;
    __syncthreads();
#pragma unroll
    for (int i = 0; i < 4; ++i) {
      int r = (tid >> 4) + 16 * i, c4 = (tid & 15) * 4;
      float4 v = *(const float4*)(src + (size_t)(k0 + r) * N + n0 + c4);
      tile[r * 65 + c4 + 0] = v.x; tile[r * 65 + c4 + 1] = v.y; tile[r * 65 + c4 + 2] = v.z; tile[r * 65 + c4 + 3] = v.w;
    }
    __syncthreads();
    int nl = tid >> 2, ks = (tid & 3) * 16;
    int n = n0 + nl;
    int drow = n;
    if (mode == 1) { drow = (n < DFF) ? ((n >> 6) * 128 + (n & 63)) : (((n - DFF) >> 6) * 128 + 64 + ((n - DFF) & 63)); }
    unsigned o[8];
#pragma unroll
    for (int j = 0; j < 8; ++j) o[j] = pack2(tile[(ks + 2 * j) * 65 + nl], tile[(ks + 2 * j + 1) * 65 + nl]);
    uint4* dp = (uint4*)(dst + (size_t)drow * ldk + k0 + ks);
    dp[0] = make_uint4(o[0], o[1], o[2], o[3]);
    dp[1] = make_uint4(o[4], o[5], o[6], o[7]);
  }
}

__device__ void build_lora(const float* __restrict__ w_up, const float* __restrict__ a_up, const float* __restrict__ g_up, bf16_t* __restrict__ dst) {
  const int total = NLORA * KLORA;
  for (int e = blockIdx.x * 256 + tid_opaque(); e < total; e += gridDim.x * 256) {
    int k = e / NLORA, n = e - k * NLORA;
    int nb = n >> 9, nl = n & 511;
    float v = 0.f;
    if (nb < 2) { int kk = k - 64 * nb; if (kk >= 0 && kk < 64) v = w_up[((size_t)nb * 64 + kk) * 512 + nl]; }
    else if (nb < 4) { int d = nb - 2; int kk = k - 128 - 64 * d; if (kk >= 0 && kk < 64) v = a_up[((size_t)d * 64 + kk) * 512 + nl]; }
    else { int kk = k - 256; if (kk >= 0 && kk < 128) v = g_up[(size_t)kk * 512 + nl]; }
    dst[(size_t)n * KLORA + k] = f2bf(v);
  }
}

__device__ void build_rotary(float2* __restrict__ rot) {
  const float invf[8] = {1.0f, 0.1939227432012558f, 0.03760603070259094f, 0.007292664609849453f, 0.0014142135623842478f,
                         0.00027424818836152554f, 5.318296098266728e-05f, 1.0313386155758053e-05f};
  for (int e = blockIdx.x * 256 + tid_opaque(); e < 16384 * 8; e += gridDim.x * 256) {
    int s = e >> 3, i = e & 7;
    float inv = invf[0];
#pragma unroll
    for (int q = 1; q < 8; ++q) inv = (i == q) ? invf[q] : inv;
    float angf = (float)s * inv;
    double a = (double)angf;
    double rev = a * 0.15915494309189535;
    rev -= rint(rev);
    double x = rev * 6.283185307179586;
    double x2 = x * x;
    double sn = 0.0, cs = 0.0;
    {
      double t = 1.0; cs = 1.0;
#pragma unroll
      for (int n = 1; n <= 13; ++n) { t = -t * x2 / (double)((2 * n - 1) * (2 * n)); cs += t; }
      double u = x; sn = x;
#pragma unroll
      for (int n = 1; n <= 13; ++n) { u = -u * x2 / (double)((2 * n) * (2 * n + 1)); sn += u; }
    }
    rot[e] = make_float2((float)cs, (float)sn);
  }
}

__device__ void ph_rmsnorm(const float* __restrict__ x, const float* __restrict__ g, bf16_t* __restrict__ hb, int T,
                           const float* __restrict__ p, bf16_t* __restrict__ pb) {
  const int lane = tid_opaque() & 63, wv = tid_opaque() >> 6;
  float4 gv[4];
#pragma unroll
  for (int i = 0; i < 4; ++i) gv[i] = *(const float4*)(g + 4 * lane + 256 * i);
  for (int row = blockIdx.x * 4 + wv; row < T; row += gridDim.x * 4) {
    const float* xr = x + (size_t)row * DM;
    float4 v[4];
    float ss = 0.f;
#pragma unroll
    for (int i = 0; i < 4; ++i) { v[i] = *(const float4*)(xr + 4 * lane + 256 * i); ss += v[i].x * v[i].x + v[i].y * v[i].y + v[i].z * v[i].z + v[i].w * v[i].w; }
    ss = wave_sum(ss);
    float rs = rsqrtf(ss * (1.0f / DM) + 1e-6f);
#pragma unroll
    for (int i = 0; i < 4; ++i) {
      uint2 o;
      o.x = pack2(v[i].x * rs * gv[i].x, v[i].y * rs * gv[i].y);
      o.y = pack2(v[i].z * rs * gv[i].z, v[i].w * rs * gv[i].w);
      *(uint2*)(hb + (size_t)row * DM + 4 * lane + 256 * i) = o;
    }
    if (p) {
      float4 pv = *(const float4*)(p + (size_t)row * PLE + 4 * lane);
      uint2 o; o.x = pack2(pv.x, pv.y); o.y = pack2(pv.z, pv.w);
      *(uint2*)(pb + (size_t)row * PLE + 4 * lane) = o;
    }
  }
}
__device__ void ph_final_norm(float* __restrict__ x, const float* __restrict__ g, int T) {
  const int lane = tid_opaque() & 63, wv = tid_opaque() >> 6;
  for (int row = blockIdx.x * 4 + wv; row < T; row += gridDim.x * 4) {
    float* xr = x + (size_t)row * DM;
    float4 v[4];
    float ss = 0.f;
#pragma unroll
    for (int i = 0; i < 4; ++i) { v[i] = *(const float4*)(xr + 4 * lane + 256 * i); ss += v[i].x * v[i].x + v[i].y * v[i].y + v[i].z * v[i].z + v[i].w * v[i].w; }
    ss = wave_sum(ss);
    float rs = rsqrtf(ss * (1.0f / DM) + 1e-6f);
#pragma unroll
    for (int i = 0; i < 4; ++i) {
      float4 gg = *(const float4*)(g + 4 * lane + 256 * i);
      float4 o = make_float4(v[i].x * rs * gg.x, v[i].y * rs * gg.y, v[i].z * rs * gg.z, v[i].w * rs * gg.w);
      *(float4*)(xr + 4 * lane + 256 * i) = o;
    }
  }
}

constexpr int LDT = 72;
constexpr int TILE_B = 128 * LDT * 2;
constexpr int SMEM_BYTES = 4 * TILE_B;

__device__ __forceinline__ void gemm_mainloop(f32x4 (&acc)[4][4], const bf16_t* __restrict__ A, long lda, int rlo, int rhi,
                                              const bf16_t* __restrict__ Bt, long ldb, int K, char* smem) {
  const int tid = tid_opaque(), lane = tid & 63, wv = tid >> 6, wm = wv >> 1, wn = wv & 1;
  const int lr = tid >> 3, lc = (tid & 7) * 8;
  uint4 ra[4], rb[4];
  const int nk = K / 64;
  auto gload = [&](int kt) {
#pragma unroll
    for (int i = 0; i < 4; ++i) {
      int r = lr + 32 * i;
      ra[i] = (r >= rlo && r < rhi) ? *(const uint4*)(A + (long)r * lda + kt * 64 + lc) : make_uint4(0, 0, 0, 0);
      rb[i] = *(const uint4*)(Bt + (long)r * ldb + kt * 64 + lc);
    }
  };
  auto sstore = [&](int buf) {
    char* sa = smem + buf * TILE_B;
    char* sb = smem + (2 + buf) * TILE_B;
#pragma unroll
    for (int i = 0; i < 4; ++i) {
      int r = lr + 32 * i;
      *(uint4*)(sa + (r * LDT + lc) * 2) = ra[i];
      *(uint4*)(sb + (r * LDT + lc) * 2) = rb[i];
    }
  };
  __syncthreads();
  gload(0);
  sstore(0);
  __syncthreads();
  for (int kt = 0; kt < nk; ++kt) {
    const int buf = kt & 1;
    if (kt + 1 < nk) gload(kt + 1);
    const char* sa = smem + buf * TILE_B;
    const char* sb = smem + (2 + buf) * TILE_B;
#pragma unroll
    for (int ks = 0; ks < 2; ++ks) {
      bf16x8 af[4], bfr[4];
#pragma unroll
      for (int m = 0; m < 4; ++m) af[m] = *(const bf16x8*)(sa + ((wm * 64 + m * 16 + (lane & 15)) * LDT + ks * 32 + (lane >> 4) * 8) * 2);
#pragma unroll
      for (int n = 0; n < 4; ++n) bfr[n] = *(const bf16x8*)(sb + ((wn * 64 + n * 16 + (lane & 15)) * LDT + ks * 32 + (lane >> 4) * 8) * 2);
#pragma unroll
      for (int m = 0; m < 4; ++m)
#pragma unroll
        for (int n = 0; n < 4; ++n) acc[m][n] = __builtin_amdgcn_mfma_f32_16x16x32_bf16(bfr[n], af[m], acc[m][n], 0, 0, 0);
    }
    if (kt + 1 < nk) sstore(buf ^ 1);
    __syncthreads();
  }
}
__device__ __forceinline__ void zero_acc(f32x4 (&acc)[4][4]) {
#pragma unroll
  for (int m = 0; m < 4; ++m)
#pragma unroll
    for (int n = 0; n < 4; ++n) acc[m][n] = (f32x4){0.f, 0.f, 0.f, 0.f};
}

#define EPI_LOOP(...)                                                                                      \
  {                                                                                                        \
    const int lane_ = tid_opaque() & 63, wv_ = tid_opaque() >> 6, wm_ = wv_ >> 1, wn_ = wv_ & 1;            \
    _Pragma("unroll") for (int m = 0; m < 4; ++m) _Pragma("unroll") for (int n = 0; n < 4; ++n) {         \
      const int row = wm_ * 64 + m * 16 + (lane_ & 15);                                                    \
      const int col = wn_ * 64 + n * 16 + (lane_ >> 4) * 4;                                                \
      const f32x4 v = acc[m][n];                                                                           \
      __VA_ARGS__                                                                                          \
    }                                                                                                      \
  }

__device__ void ph_gemm_ab(const bf16_t* __restrict__ hb, const bf16_t* __restrict__ W, bf16_t* __restrict__ z1, bf16_t* __restrict__ z2, char* smem) {
  const int nt_n = AB_IN / 128, ntiles = (TG / 128) * nt_n;
  for (int t0 = blockIdx.x; t0 < ntiles; t0 += gridDim.x) {
    int t = tile_remap(t0, ntiles);
    int tm = t / nt_n, tn = t % nt_n;
    f32x4 acc[4][4]; zero_acc(acc);
    gemm_mainloop(acc, hb + (size_t)tm * 128 * DM, DM, 0, 128, W + (size_t)tn * 128 * DM, DM, DM, smem);
    bf16_t* dst; int ldc, c0;
    if (tn < 15) { dst = z1; ldc = RWKV_IN; c0 = tn * 128; } else { dst = z2; ldc = ATT_IN; c0 = (tn - 15) * 128; }
    EPI_LOOP({
      uint2 o; o.x = pack2(v[0], v[1]); o.y = pack2(v[2], v[3]);
      *(uint2*)(dst + (size_t)(tm * 128 + row) * ldc + c0 + col) = o;
    })
  }
}

__device__ void ph_gemm_lora(const bf16_t* __restrict__ L, const bf16_t* __restrict__ W, const float* __restrict__ w0, const float* __restrict__ a0,
                             bf16_t* __restrict__ ea, bf16_t* __restrict__ gb, char* smem) {
  const int nt_n = NLORA / 128, ntiles = (TG / 128) * nt_n;
  for (int t0 = blockIdx.x; t0 < ntiles; t0 += gridDim.x) {
    int t = tile_remap(t0, ntiles);
    int tm = t / nt_n, tn = t % nt_n;
    f32x4 acc[4][4]; zero_acc(acc);
    gemm_mainloop(acc, L + (size_t)tm * 128 * KLORA, KLORA, 0, 128, W + (size_t)tn * 128 * KLORA, KLORA, KLORA, smem);
    EPI_LOOP({
      int nc = tn * 128 + col;
      float o0, o1, o2, o3;
      if (tn < 8) {
        float4 b = *(const float4*)(w0 + nc);
        o0 = 0.60653066f * sigmoidf_(v[0] + b.x); o1 = 0.60653066f * sigmoidf_(v[1] + b.y);
        o2 = 0.60653066f * sigmoidf_(v[2] + b.z); o3 = 0.60653066f * sigmoidf_(v[3] + b.w);
      } else if (tn < 16) {
        float4 b = *(const float4*)(a0 + nc - 1024);
        o0 = sigmoidf_(v[0] + b.x); o1 = sigmoidf_(v[1] + b.y); o2 = sigmoidf_(v[2] + b.z); o3 = sigmoidf_(v[3] + b.w);
      } else { o0 = v[0]; o1 = v[1]; o2 = v[2]; o3 = v[3]; }
      uint2 o; o.x = pack2(o0, o1); o.y = pack2(o2, o3);
      if (tn < 16) *(uint2*)(ea + (size_t)(tm * 128 + row) * 2048 + nc) = o;
      else *(uint2*)(gb + (size_t)(tm * 128 + row) * RW + nc - 2048) = o;
    })
  }
}

__device__ void ph_gemm_res(const bf16_t* __restrict__ A, int K, const bf16_t* __restrict__ W, const float* xsrc, float* xdst, char* smem) {
  const int nt_n = DM / 128, ntiles = (TG / 128) * nt_n;
  for (int t0 = blockIdx.x; t0 < ntiles; t0 += gridDim.x) {
    int t = tile_remap(t0, ntiles);
    int tm = t / nt_n, tn = t % nt_n;
    f32x4 acc[4][4]; zero_acc(acc);
    gemm_mainloop(acc, A + (size_t)tm * 128 * K, K, 0, 128, W + (size_t)tn * 128 * K, K, K, smem);
    EPI_LOOP({
      size_t idx = (size_t)(tm * 128 + row) * DM + tn * 128 + col;
      float4 xs = *(const float4*)(xsrc + idx);
      *(float4*)(xdst + idx) = make_float4(xs.x + v[0], xs.y + v[1], xs.z + v[2], xs.w + v[3]);
    })
  }
}

__device__ void ph_gemm_bf16(const bf16_t* __restrict__ A, int lda, int K, int grouped, const bf16_t* __restrict__ W, const float* __restrict__ scale,
                             bf16_t* __restrict__ out, char* smem) {
  const int nt_n = DM / 128, ntiles = (TG / 128) * nt_n;
  for (int t0 = blockIdx.x; t0 < ntiles; t0 += gridDim.x) {
    int t = tile_remap(t0, ntiles);
    int tm = t / nt_n, tn = t % nt_n;
    f32x4 acc[4][4]; zero_acc(acc);
    int aoff = grouped ? (tn >> 1) * 256 : 0;
    gemm_mainloop(acc, A + (size_t)tm * 128 * lda + aoff, lda, 0, 128, W + (size_t)tn * 128 * K, K, K, smem);
    EPI_LOOP({
      int nc = tn * 128 + col;
      float4 s = scale ? *(const float4*)(scale + nc) : make_float4(1.f, 1.f, 1.f, 1.f);
      uint2 o; o.x = pack2(v[0] * s.x, v[1] * s.y); o.y = pack2(v[2] * s.z, v[3] * s.w);
      *(uint2*)(out + (size_t)(tm * 128 + row) * DM + nc) = o;
    })
  }
}

__device__ void ph_ffn_up(const bf16_t* __restrict__ hb, const bf16_t* __restrict__ W, const float* __restrict__ cw, const float* __restrict__ cb,
                          bf16_t* __restrict__ act, int B, int S, char* smem) {
  const int nts = (S + 125) / 126;
  const int nt_n = UP / 128;
  const int ntiles = B * nts * nt_n;
  float* U = (float*)smem;
  for (int t0 = blockIdx.x; t0 < ntiles; t0 += gridDim.x) {
    int t = tile_remap(t0, ntiles);
    int tn = t % nt_n, tmm = t / nt_n;
    int b = tmm / nts, ti = tmm % nts;
    int s0 = ti * 126 - 1;
    int rlo = (s0 < 0) ? -s0 : 0;
    int rhi = (S - s0 < 128) ? (S - s0) : 128;
    f32x4 acc[4][4]; zero_acc(acc);
    gemm_mainloop(acc, hb + ((long)b * S + s0) * DM, DM, rlo, rhi, W + (size_t)tn * 128 * DM, DM, DM, smem);
    EPI_LOOP({
      *(float4*)(U + row * 132 + col) = make_float4(v[0], v[1], v[2], v[3]);
    })
    __syncthreads();
    {
      const int cq = (tid_opaque() & 15) * 4, rg = tid_opaque() >> 4;
      const int cg_ = tn * 64 + cq;
      float4 g0 = *(const float4*)(cw + cg_), g1 = *(const float4*)(cw + UP + cg_), g2 = *(const float4*)(cw + 2 * UP + cg_), gb = *(const float4*)(cb + cg_);
      float4 v0 = *(const float4*)(cw + DFF + cg_), v1 = *(const float4*)(cw + UP + DFF + cg_), v2 = *(const float4*)(cw + 2 * UP + DFF + cg_), vb = *(const float4*)(cb + DFF + cg_);
#pragma unroll
      for (int i = 0; i < 8; ++i) {
        int r = 1 + rg + 16 * i;
        int s = s0 + r;
        if (r <= 126 && s < S) {
          float4 a0 = *(const float4*)(U + (r - 1) * 132 + cq), a1 = *(const float4*)(U + r * 132 + cq), a2 = *(const float4*)(U + (r + 1) * 132 + cq);
          float4 b0 = *(const float4*)(U + (r - 1) * 132 + 64 + cq), b1 = *(const float4*)(U + r * 132 + 64 + cq), b2 = *(const float4*)(U + (r + 1) * 132 + 64 + cq);
          float gx = a0.x * g0.x + a1.x * g1.x + a2.x * g2.x + gb.x, gy = a0.y * g0.y + a1.y * g1.y + a2.y * g2.y + gb.y;
          float gz = a0.z * g0.z + a1.z * g1.z + a2.z * g2.z + gb.z, gw = a0.w * g0.w + a1.w * g1.w + a2.w * g2.w + gb.w;
          float vx = b0.x * v0.x + b1.x * v1.x + b2.x * v2.x + vb.x, vy = b0.y * v0.y + b1.y * v1.y + b2.y * v2.y + vb.y;
          float vz = b0.z * v0.z + b1.z * v1.z + b2.z * v2.z + vb.z, vw = b0.w * v0.w + b1.w * v1.w + b2.w * v2.w + vb.w;
          uint2 o; o.x = pack2(gelu_tanh(gx) * vx, gelu_tanh(gy) * vy); o.y = pack2(gelu_tanh(gz) * vz, gelu_tanh(gw) * vw);
          *(uint2*)(act + ((size_t)b * S + s) * DFF + cg_) = o;
        }
      }
    }
  }
}

__device__ void ph_ple(const bf16_t* __restrict__ hb, const bf16_t* __restrict__ Wg, const float* __restrict__ bg, const bf16_t* __restrict__ pb,
                       const bf16_t* __restrict__ Wp, float* x, char* smem) {
  const int nt_n = DM / 128, ntiles = (TG / 128) * nt_n;
  for (int t0 = blockIdx.x; t0 < ntiles; t0 += gridDim.x) {
    int t = tile_remap(t0, ntiles);
    int tm = t / nt_n, tn = t % nt_n;
    uint2 pj[4][4];
    {
      f32x4 acc[4][4]; zero_acc(acc);
      gemm_mainloop(acc, pb + (size_t)tm * 128 * PLE, PLE, 0, 128, Wp + (size_t)tn * 128 * PLE, PLE, PLE, smem);
#pragma unroll
      for (int m = 0; m < 4; ++m)
#pragma unroll
        for (int n = 0; n < 4; ++n) { pj[m][n].x = pack2(acc[m][n][0], acc[m][n][1]); pj[m][n].y = pack2(acc[m][n][2], acc[m][n][3]); }
    }
    f32x4 acc[4][4]; zero_acc(acc);
    gemm_mainloop(acc, hb + (size_t)tm * 128 * DM, DM, 0, 128, Wg + (size_t)tn * 128 * DM, DM, DM, smem);
    EPI_LOOP({
      size_t idx = (size_t)(tm * 128 + row) * DM + tn * 128 + col;
      float4 b = *(const float4*)(bg + tn * 128 + col);
      uint2 pq = pj[m][n];
      float4 xs = *(const float4*)(x + idx);
      xs.x += sigmoidf_(v[0] + b.x) * lo2f(pq.x); xs.y += sigmoidf_(v[1] + b.y) * hi2f(pq.x);
      xs.z += sigmoidf_(v[2] + b.z) * lo2f(pq.y); xs.w += sigmoidf_(v[3] + b.w) * hi2f(pq.y);
      *(float4*)(x + idx) = xs;
    })
  }
}

__device__ void ph_attention(const bf16_t* __restrict__ z2, const float2* __restrict__ rot, float* __restrict__ opart, float* __restrict__ lsep,
                             int B, int S, char* smem) {
  bf16_t* sK = (bf16_t*)smem;
  bf16_t* sVt = (bf16_t*)(smem + 192 * 72 * 2);
  const int tid = tid_opaque(), lane = tid & 63, w4 = tid >> 6, quad = lane >> 4, l15 = lane & 15;
  const int tps = S / 64;
  const int per_g = B * 4 * tps;
  const int nunits = 3 * per_g;
  for (int u = blockIdx.x; u < nunits; u += gridDim.x) {
    int g = u / per_g, rem = u % per_g;
    int b = rem / (4 * tps), rem2 = rem % (4 * tps);
    int hg = rem2 / tps, w = rem2 % tps;
    int dil = (g == 0) ? 1 : (g == 1 ? 4 : 16);
    int Ls = S / dil;
    int lt = w / dil, rho = w % dil;
    int l0 = lt * 64;
    int head = g * 4 + hg;
    const bf16_t* zb = z2 + (size_t)b * S * ATT_IN;
    __syncthreads();
#pragma unroll
    for (int it = 0; it < 3; ++it) {
      int e = tid + 256 * it;
      int jj = e >> 2, part = e & 3;
      int lk = l0 - 64 + jj;
      bool valid = (lk >= 0) && (lk < Ls);
      int s = lk * dil + rho;
      uint4 k0 = make_uint4(0, 0, 0, 0), k1 = k0, v0 = k0, v1 = k0;
      if (valid) {
        const bf16_t* kr = zb + (size_t)s * ATT_IN + 768 + head * 64 + part * 16;
        const bf16_t* vr = zb + (size_t)s * ATT_IN + 1536 + head * 64 + part * 16;
        k0 = *(const uint4*)kr; k1 = *(const uint4*)(kr + 8);
        v0 = *(const uint4*)vr; v1 = *(const uint4*)(vr + 8);
        if (part == 0) {
          const float2* rt = rot + (size_t)s * 8;
          unsigned x1[4] = {k0.x, k0.y, k0.z, k0.w}, x2[4] = {k1.x, k1.y, k1.z, k1.w};
#pragma unroll
          for (int q = 0; q < 4; ++q) {
            float2 c0 = rt[2 * q], c1 = rt[2 * q + 1];
            float a0 = lo2f(x1[q]), a1 = hi2f(x1[q]), b0 = lo2f(x2[q]), b1 = hi2f(x2[q]);
            x1[q] = pack2(a0 * c0.x - b0 * c0.y, a1 * c1.x - b1 * c1.y);
            x2[q] = pack2(b0 * c0.x + a0 * c0.y, b1 * c1.x + a1 * c1.y);
          }
          k0 = make_uint4(x1[0], x1[1], x1[2], x1[3]); k1 = make_uint4(x2[0], x2[1], x2[2], x2[3]);
        }
      }
      *(uint4*)(sK + jj * 72 + part * 16) = k0;
      *(uint4*)(sK + jj * 72 + part * 16 + 8) = k1;
      unsigned vv[8] = {v0.x, v0.y, v0.z, v0.w, v1.x, v1.y, v1.z, v1.w};
#pragma unroll
      for (int q = 0; q < 8; ++q) {
        sVt[(part * 16 + 2 * q) * 200 + jj] = (bf16_t)(vv[q] & 0xffffu);
        sVt[(part * 16 + 2 * q + 1) * 200 + jj] = (bf16_t)(vv[q] >> 16);
      }
    }
    const int qi = w4 * 16 + l15;
    const int sq = (l0 + qi) * dil + rho;
    bf16x8 qf[2];
    {
      const bf16_t* qr = zb + (size_t)sq * ATT_IN + head * 64;
      uint4 c[2];
      c[0] = *(const uint4*)(qr + quad * 8);
      c[1] = *(const uint4*)(qr + 32 + quad * 8);
      unsigned xs[4] = {c[0].x, c[0].y, c[0].z, c[0].w};
      if (quad < 2) {
        uint4 oth = *(const uint4*)(qr + (quad ^ 1) * 8);
        unsigned xo[4] = {oth.x, oth.y, oth.z, oth.w};
        const float2* rt = rot + (size_t)sq * 8;
#pragma unroll
        for (int q = 0; q < 4; ++q) {
          float2 c0 = rt[2 * q], c1 = rt[2 * q + 1];
          float a0 = lo2f(xs[q]), a1 = hi2f(xs[q]), b0 = lo2f(xo[q]), b1 = hi2f(xo[q]);
          float r0 = (quad == 0) ? (a0 * c0.x - b0 * c0.y) : (a0 * c0.x + b0 * c0.y);
          float r1 = (quad == 0) ? (a1 * c1.x - b1 * c1.y) : (a1 * c1.x + b1 * c1.y);
          xs[q] = pack2(r0, r1);
        }
      }
      unsigned all[8] = {xs[0], xs[1], xs[2], xs[3], c[1].x, c[1].y, c[1].z, c[1].w};
#pragma unroll
      for (int q = 0; q < 8; ++q) all[q] = pack2(lo2f(all[q]) * 0.125f, hi2f(all[q]) * 0.125f);
      uint4 t0 = make_uint4(all[0], all[1], all[2], all[3]), t1 = make_uint4(all[4], all[5], all[6], all[7]);
      qf[0] = *(bf16x8*)&t0; qf[1] = *(bf16x8*)&t1;
    }
    __syncthreads();
    const int kt0 = (w4 < 2) ? w4 : 2;
    f32x4 sc[10];
#pragma unroll
    for (int kt = 0; kt < 10; ++kt) {
      f32x4 a = (f32x4){0.f, 0.f, 0.f, 0.f};
#pragma unroll
      for (int ks = 0; ks < 2; ++ks) {
        bf16x8 kf = *(const bf16x8*)(sK + ((kt0 + kt) * 16 + l15) * 72 + ks * 32 + quad * 8);
        a = __builtin_amdgcn_mfma_f32_16x16x32_bf16(kf, qf[ks], a, 0, 0, 0);
      }
      sc[kt] = a;
    }
    float mx = -1e30f;
#pragma unroll
    for (int kt = 0; kt < 10; ++kt)
#pragma unroll
      for (int r = 0; r < 4; ++r) {
        int jj = (kt0 + kt) * 16 + quad * 4 + r;
        int lk = l0 - 64 + jj;
        bool valid = (jj >= qi) && (jj <= qi + 128) && (lk >= 0) && (lk < Ls);
        float sv = valid ? sc[kt][r] : -1e30f;
        sc[kt][r] = sv;
        mx = fmaxf(mx, sv);
      }
    mx = fmaxf(mx, __shfl_xor(mx, 16, 64));
    mx = fmaxf(mx, __shfl_xor(mx, 32, 64));
    float den = 0.f;
#pragma unroll
    for (int kt = 0; kt < 10; ++kt)
#pragma unroll
      for (int r = 0; r < 4; ++r) { float p = __expf(sc[kt][r] - mx); sc[kt][r] = p; den += p; }
    den += __shfl_xor(den, 16, 64);
    den += __shfl_xor(den, 32, 64);
    f32x4 oacc[4];
#pragma unroll
    for (int dt = 0; dt < 4; ++dt) oacc[dt] = (f32x4){0.f, 0.f, 0.f, 0.f};
#pragma unroll
    for (int pp = 0; pp < 5; ++pp) {
      uint4 pk = make_uint4(pack2(sc[2 * pp][0], sc[2 * pp][1]), pack2(sc[2 * pp][2], sc[2 * pp][3]),
                            pack2(sc[2 * pp + 1][0], sc[2 * pp + 1][1]), pack2(sc[2 * pp + 1][2], sc[2 * pp + 1][3]));
      bf16x8 pf = *(bf16x8*)&pk;
#pragma unroll
      for (int dt = 0; dt < 4; ++dt) {
        const bf16_t* vp = sVt + (dt * 16 + l15) * 200 + (kt0 + 2 * pp) * 16 + quad * 4;
        uint2 va = *(const uint2*)vp, vb = *(const uint2*)(vp + 16);
        uint4 vk = make_uint4(va.x, va.y, vb.x, vb.y);
        bf16x8 vf = *(bf16x8*)&vk;
        oacc[dt] = __builtin_amdgcn_mfma_f32_16x16x32_bf16(vf, pf, oacc[dt], 0, 0, 0);
      }
    }
    float inv = 1.0f / den;
    float* op = opart + ((size_t)g * TG + (size_t)b * S + sq) * 256 + hg * 64;
#pragma unroll
    for (int dt = 0; dt < 4; ++dt)
      *(float4*)(op + dt * 16 + quad * 4) = make_float4(oacc[dt][0] * inv, oacc[dt][1] * inv, oacc[dt][2] * inv, oacc[dt][3] * inv);
    if (quad == 0) lsep[((size_t)g * TG + (size_t)b * S + sq) * 4 + hg] = mx + __logf(den);
  }
}

__device__ void ph_attn_combine(const float* __restrict__ opart, const float* __restrict__ lsep, bf16_t* __restrict__ yab) {
  const int total = TG * 64;
  for (int e = blockIdx.x * 256 + tid_opaque(); e < total; e += gridDim.x * 256) {
    int t = e >> 6, c = (e & 63) * 4, hg = c >> 6;
    float l0 = lsep[(size_t)t * 4 + hg], l1 = lsep[((size_t)TG + t) * 4 + hg], l2 = lsep[((size_t)2 * TG + t) * 4 + hg];
    float m = fmaxf(l0, fmaxf(l1, l2));
    float w0 = __expf(l0 - m), w1 = __expf(l1 - m), w2 = __expf(l2 - m);
    float inv = 1.0f / (w0 + w1 + w2);
    w0 *= inv; w1 *= inv; w2 *= inv;
    float4 a = *(const float4*)(opart + (size_t)t * 256 + c);
    float4 b = *(const float4*)(opart + ((size_t)TG + t) * 256 + c);
    float4 d = *(const float4*)(opart + ((size_t)2 * TG + t) * 256 + c);
    uint2 o;
    o.x = pack2(w0 * a.x + w1 * b.x + w2 * d.x, w0 * a.y + w1 * b.y + w2 * d.y);
    o.y = pack2(w0 * a.z + w1 * b.z + w2 * d.z, w0 * a.w + w1 * b.w + w2 * d.w);
    *(uint2*)(yab + (size_t)t * AB_OUT + 512 + c) = o;
  }
}

__device__ void ph_rwkv_prep(const bf16_t* __restrict__ z1, const float* __restrict__ mu, bf16_t* __restrict__ rkv, bf16_t* __restrict__ L, int S) {
  const int lane = tid_opaque() & 63, wv = tid_opaque() >> 6;
  for (int t = blockIdx.x * 4 + wv; t < TG; t += gridDim.x * 4) {
    int s = t % S;
    const bf16_t* zc = z1 + (size_t)t * RWKV_IN;
#pragma unroll
    for (int i = 0; i < 15; ++i) {
      int c = 2 * (lane + 64 * i);
      unsigned uc = *(const unsigned*)(zc + c);
      unsigned um = (s > 0) ? *(const unsigned*)(zc - RWKV_IN + c) : 0u;
      unsigned up = (s < S - 1) ? *(const unsigned*)(zc + RWKV_IN + c) : 0u;
      float2 m2 = *(const float2*)(mu + c);
      float z0 = lo2f(uc), z1v = hi2f(uc);
      float r0 = z0 + m2.x * (0.5f * (lo2f(um) + lo2f(up)) - z0);
      float r1 = z1v + m2.y * (0.5f * (hi2f(um) + hi2f(up)) - z1v);
      if (c < 1536) {
        *(unsigned*)(rkv + (size_t)t * 1536 + c) = pack2(r0, r1);
      } else {
        if (c < 1664) { r0 = tanhf_(r0); r1 = tanhf_(r1); }
        else if (c >= 1792) { r0 = sigmoidf_(r0); r1 = sigmoidf_(r1); }
        *(unsigned*)(L + (size_t)t * KLORA + c - 1536) = pack2(r0, r1);
      }
    }
  }
}

__device__ __forceinline__ void scan_stage(float* st, const bf16_t* __restrict__ rkv, const bf16_t* __restrict__ ea, float kkp, float kap,
                                           int b, int S, int h, int d, int tau0, int lane) {
#pragma unroll
  for (int i = 0; i < TB; ++i) {
    int tau = tau0 + i;
    int tt = (d == 0) ? tau : (S - 1 - tau);
    size_t row = (size_t)b * S + tt;
    float rv = bf2f(rkv[row * 1536 + h * 64 + lane]);
    float kv = bf2f(rkv[row * 1536 + 512 + h * 64 + lane]);
    float vv = bf2f(rkv[row * 1536 + 1024 + h * 64 + lane]);
    float e = bf2f(ea[row * 2048 + d * 512 + h * 64 + lane]);
    float a = bf2f(ea[row * 2048 + 1024 + d * 512 + h * 64 + lane]);
    float p = kv * kkp;
    float ss = wave_sum(p * p);
    float kk = p * rsqrtf(ss + 1e-12f);
    float* s = st + i * 384;
    s[lane] = kk;
    s[64 + lane] = __expf(-e);
    s[128 + lane] = kk * a;
    s[192 + lane] = kv * (1.0f + (a - 1.0f) * kap);
    s[256 + lane] = rv;
    s[320 + lane] = vv;
  }
}

__device__ void ph_scan_pass1(const bf16_t* __restrict__ rkv, const bf16_t* __restrict__ ea, const float* __restrict__ k_k, const float* __restrict__ k_a,
                              float* __restrict__ Qb, float* __restrict__ Mb, int B, int S, char* smem) {
  const int NC = S / CHUNK_L;
  if (NC <= 1) return;
  const int lane = tid_opaque() & 63, wv = tid_opaque() >> 6;
  float* st = (float*)smem + wv * (TB * 384);
  const int nunits = B * 8 * 2 * (NC - 1) * 2;
  for (int u2 = wv * gridDim.x + blockIdx.x; u2 < nunits; u2 += 4 * gridDim.x) {
    const int isM = u2 & 1, u = u2 >> 1;
    int ci = u % (NC - 1), bhd = u / (NC - 1);
    int d = bhd & 1, h = (bhd >> 1) & 7, b = bhd >> 4;
    float kkp = k_k[h * 64 + lane], kap = k_a[h * 64 + lane];
    float Sq[64];
#pragma unroll
    for (int k = 0; k < 64; ++k) Sq[k] = (isM && k == lane) ? 1.f : 0.f;
    const float vsel = isM ? 0.f : 1.f;
    for (int tb = 0; tb < CHUNK_L / TB; ++tb) {
      scan_stage(st, rkv, ea, kkp, kap, b, S, h, d, ci * CHUNK_L + tb * TB, lane);
      for (int i = 0; i < TB; ++i) {
        const float* s = st + i * 384;
        float sa0 = 0.f, sa1 = 0.f;
#pragma unroll
        for (int q = 0; q < 16; ++q) {
          float4 k4 = *(const float4*)(s + 4 * q);
          sa0 += Sq[4 * q] * k4.x; sa1 += Sq[4 * q + 1] * k4.y; sa0 += Sq[4 * q + 2] * k4.z; sa1 += Sq[4 * q + 3] * k4.w;
        }
        float sa = sa0 + sa1;
        float vv = s[320 + lane] * vsel;
#pragma unroll
        for (int q = 0; q < 16; ++q) {
          float4 w4 = *(const float4*)(s + 64 + 4 * q), a4 = *(const float4*)(s + 128 + 4 * q), d4 = *(const float4*)(s + 192 + 4 * q);
          Sq[4 * q] = Sq[4 * q] * w4.x - sa * a4.x + vv * d4.x;
          Sq[4 * q + 1] = Sq[4 * q + 1] * w4.y - sa * a4.y + vv * d4.y;
          Sq[4 * q + 2] = Sq[4 * q + 2] * w4.z - sa * a4.z + vv * d4.z;
          Sq[4 * q + 3] = Sq[4 * q + 3] * w4.w - sa * a4.w + vv * d4.w;
        }
      }
    }
    float* qo = (isM ? Mb : Qb) + ((size_t)bhd * NC + ci) * 4096 + lane * 64;
#pragma unroll
    for (int q = 0; q < 16; ++q) *(float4*)(qo + 4 * q) = make_float4(Sq[4 * q], Sq[4 * q + 1], Sq[4 * q + 2], Sq[4 * q + 3]);
  }
}

__device__ void ph_scan_pass2(const float* __restrict__ Qb, const float* __restrict__ Mb, float* __restrict__ Sib, int B, int S, char* smem) {
  const int NC = S / CHUNK_L;
  if (NC <= 1) return;
  float* sS = (float*)smem;
  float* sM = sS + 64 * 65;
  const int tid = tid_opaque(), v = tid >> 2, q = tid & 3;
  for (int bhd = blockIdx.x; bhd < B * 16; bhd += gridDim.x) {
    float cur[16];
#pragma unroll
    for (int i = 0; i < 16; ++i) cur[i] = 0.f;
    for (int c = 0; c < NC; ++c) {
      float* so = Sib + ((size_t)bhd * NC + c) * 4096 + v * 64 + q * 16;
#pragma unroll
      for (int i = 0; i < 4; ++i) *(float4*)(so + 4 * i) = make_float4(cur[4 * i], cur[4 * i + 1], cur[4 * i + 2], cur[4 * i + 3]);
      if (c == NC - 1) break;
      __syncthreads();
#pragma unroll
      for (int i = 0; i < 16; ++i) sS[v * 65 + q * 16 + i] = cur[i];
      const float* mp = Mb + ((size_t)bhd * NC + c) * 4096;
#pragma unroll
      for (int i = 0; i < 4; ++i) *(float4*)(sM + (tid + 256 * i) * 4) = *(const float4*)(mp + (tid + 256 * i) * 4);
      __syncthreads();
      const float* qp = Qb + ((size_t)bhd * NC + c) * 4096 + v * 64 + q * 16;
      float nw[16];
#pragma unroll
      for (int i = 0; i < 4; ++i) { float4 t4 = *(const float4*)(qp + 4 * i); nw[4 * i] = t4.x; nw[4 * i + 1] = t4.y; nw[4 * i + 2] = t4.z; nw[4 * i + 3] = t4.w; }
      for (int j = 0; j < 64; ++j) {
        float sv = sS[v * 65 + j];
#pragma unroll
        for (int i = 0; i < 4; ++i) {
          float4 m4 = *(const float4*)(sM + j * 64 + q * 16 + 4 * i);
          nw[4 * i] += sv * m4.x; nw[4 * i + 1] += sv * m4.y; nw[4 * i + 2] += sv * m4.z; nw[4 * i + 3] += sv * m4.w;
        }
      }
#pragma unroll
      for (int i = 0; i < 16; ++i) cur[i] = nw[i];
    }
    __syncthreads();
  }
}

__device__ void ph_scan_pass3(const bf16_t* __restrict__ rkv, const bf16_t* __restrict__ ea, const float* __restrict__ k_k, const float* __restrict__ k_a,
                              const float* __restrict__ Sib, bf16_t* __restrict__ yp, int B, int S, char* smem) {
  const int NC = S / CHUNK_L;
  const int lane = tid_opaque() & 63, wv = tid_opaque() >> 6;
  float* st = (float*)smem + wv * (TB * 384);
  const int nunits = B * 16 * NC;
  for (int u = wv * gridDim.x + blockIdx.x; u < nunits; u += 4 * gridDim.x) {
    int ci = u % NC, bhd = u / NC;
    int d = bhd & 1, h = (bhd >> 1) & 7, b = bhd >> 4;
    float kkp = k_k[h * 64 + lane], kap = k_a[h * 64 + lane];
    float Sq[64];
    if (NC > 1) {
      const float* si = Sib + ((size_t)bhd * NC + ci) * 4096 + lane * 64;
#pragma unroll
      for (int q = 0; q < 16; ++q) { float4 t4 = *(const float4*)(si + 4 * q); Sq[4 * q] = t4.x; Sq[4 * q + 1] = t4.y; Sq[4 * q + 2] = t4.z; Sq[4 * q + 3] = t4.w; }
    } else {
#pragma unroll
      for (int k = 0; k < 64; ++k) Sq[k] = 0.f;
    }
    for (int tb = 0; tb < CHUNK_L / TB; ++tb) {
      int tau0 = ci * CHUNK_L + tb * TB;
      scan_stage(st, rkv, ea, kkp, kap, b, S, h, d, tau0, lane);
      for (int i = 0; i < TB; ++i) {
        const float* s = st + i * 384;
        float sa0 = 0.f, sa1 = 0.f;
#pragma unroll
        for (int q = 0; q < 16; ++q) {
          float4 k4 = *(const float4*)(s + 4 * q);
          sa0 += Sq[4 * q] * k4.x; sa1 += Sq[4 * q + 1] * k4.y; sa0 += Sq[4 * q + 2] * k4.z; sa1 += Sq[4 * q + 3] * k4.w;
        }
        float sa = sa0 + sa1;
        float vv = s[320 + lane];
        float y0 = 0.f, y1 = 0.f;
#pragma unroll
        for (int q = 0; q < 16; ++q) {
          float4 w4 = *(const float4*)(s + 64 + 4 * q), a4 = *(const float4*)(s + 128 + 4 * q), d4 = *(const float4*)(s + 192 + 4 * q), r4 = *(const float4*)(s + 256 + 4 * q);
          Sq[4 * q] = Sq[4 * q] * w4.x - sa * a4.x + vv * d4.x;
          Sq[4 * q + 1] = Sq[4 * q + 1] * w4.y - sa * a4.y + vv * d4.y;
          Sq[4 * q + 2] = Sq[4 * q + 2] * w4.z - sa * a4.z + vv * d4.z;
          Sq[4 * q + 3] = Sq[4 * q + 3] * w4.w - sa * a4.w + vv * d4.w;
          y0 += Sq[4 * q] * r4.x; y1 += Sq[4 * q + 1] * r4.y; y0 += Sq[4 * q + 2] * r4.z; y1 += Sq[4 * q + 3] * r4.w;
        }
        int tau = tau0 + i;
        int tt = (d == 0) ? tau : (S - 1 - tau);
        yp[((size_t)d * TG + (size_t)b * S + tt) * RW + h * 64 + lane] = f2bf(y0 + y1);
      }
    }
  }
}

__device__ void ph_rwkv_post(const bf16_t* __restrict__ yp, const bf16_t* __restrict__ rkv, const bf16_t* __restrict__ ea, const bf16_t* __restrict__ gb,
                             const float* __restrict__ k_a, const float* __restrict__ r_k, const float* __restrict__ ln_g, const float* __restrict__ ln_b,
                             bf16_t* __restrict__ yab) {
  const int lane = tid_opaque() & 63, wv = tid_opaque() >> 6;
  for (int t = blockIdx.x * 4 + wv; t < TG; t += gridDim.x * 4) {
#pragma unroll
    for (int h = 0; h < 8; ++h) {
      int c = h * 64 + lane;
      float y = bf2f(yp[(size_t)t * RW + c]) + bf2f(yp[((size_t)TG + t) * RW + c]);
      float mean = wave_sum(y) * (1.0f / 64.0f);
      float dv = y - mean;
      float var = wave_sum(dv * dv) * (1.0f / 64.0f);
      float yn = dv * rsqrtf(var + 64e-5f) * ln_g[c] + ln_b[c];
      float r = bf2f(rkv[(size_t)t * 1536 + c]), k = bf2f(rkv[(size_t)t * 1536 + 512 + c]), v = bf2f(rkv[(size_t)t * 1536 + 1024 + c]);
      float a0 = bf2f(ea[(size_t)t * 2048 + 1024 + c]), a1 = bf2f(ea[(size_t)t * 2048 + 1536 + c]);
      float ka = k_a[c];
      float kd = k * (2.0f + (a0 + a1 - 2.0f) * ka);
      float bon = wave_sum(r * kd * r_k[c]);
      float g = bf2f(gb[(size_t)t * RW + c]);
      yab[(size_t)t * AB_OUT + c] = f2bf((yn + bon * v) * g);
    }
  }
}

__device__ void ph_pool(const bf16_t* __restrict__ u, bf16_t* __restrict__ dd, int S) {
  const int total = TG * 128;
  for (int e = blockIdx.x * 256 + tid_opaque(); e < total; e += gridDim.x * 256) {
    int t = e >> 7, c = (e & 127) * 8;
    int s = t % S;
    int g = c >> 8;
    int rad = 1 << g;
    int lo = (s - rad < 0) ? 0 : s - rad;
    int hi = (s + rad + 1 > S) ? S : s + rad + 1;
    float acc[8];
#pragma unroll
    for (int i = 0; i < 8; ++i) acc[i] = 0.f;
    const bf16_t* base = u + (size_t)(t - s) * DM + c;
    for (int sp = lo; sp < hi; ++sp) {
      uint4 q = *(const uint4*)(base + (size_t)sp * DM);
      acc[0] += lo2f(q.x); acc[1] += hi2f(q.x); acc[2] += lo2f(q.y); acc[3] += hi2f(q.y);
      acc[4] += lo2f(q.z); acc[5] += hi2f(q.z); acc[6] += lo2f(q.w); acc[7] += hi2f(q.w);
    }
    float inv = 1.0f / (float)(hi - lo);
    uint4 q = *(const uint4*)(base + (size_t)s * DM);
    uint4 o;
    o.x = pack2(acc[0] * inv - lo2f(q.x), acc[1] * inv - hi2f(q.x));
    o.y = pack2(acc[2] * inv - lo2f(q.y), acc[3] * inv - hi2f(q.y));
    o.z = pack2(acc[4] * inv - lo2f(q.z), acc[5] * inv - hi2f(q.z));
    o.w = pack2(acc[6] * inv - lo2f(q.w), acc[7] * inv - hi2f(q.w));
    *(uint4*)(dd + (size_t)t * DM + c) = o;
  }
}

__global__ void __launch_bounds__(256, 2) mega(Params P) {
  cg::grid_group grid = cg::this_grid();
  extern __shared__ __attribute__((aligned(16))) char smem[];
  char* ws = P.ws;
  bf16_t* Wb = (bf16_t*)(ws + OFF_W);
  float2* rot = (float2*)(ws + OFF_ROT);

  for (int j = 0; j < 2; ++j) {
    bf16_t* we = Wb + WOFF_EVEN + (size_t)j * W_EVEN;
    transpose_w(P.in[4] + (size_t)j * DM * AB_IN, DM, AB_IN, we, DM, 0, smem);
    transpose_w(P.in[5] + (size_t)j * AB_OUT * DM, AB_OUT, DM, we + W_AB, AB_OUT, 0, smem);
    build_lora(P.in[8] + (size_t)j * 2 * 64 * RW, P.in[10] + (size_t)j * 2 * 64 * RW, P.in[11] + (size_t)j * 128 * RW, we + W_AB + W_ABO);
    bf16_t* wo = Wb + WOFF_ODD + (size_t)j * W_ODD;
    transpose_w(P.in[17] + (size_t)j * DM * DM, DM, DM, wo, DM, 0, smem);
    for (int g = 0; g < 4; ++g) transpose_w(P.in[18] + ((size_t)j * 4 + g) * 256 * 256, 256, 256, wo + W_CIN + (size_t)g * 256 * 256, 256, 0, smem);
    transpose_w(P.in[20] + (size_t)j * DM * DM, DM, DM, wo + W_CIN + W_GRP, DM, 0, smem);
  }
  for (int i = 0; i < 4; ++i) {
    bf16_t* wl = Wb + WOFF_LAYER + (size_t)i * W_LAYER;
    transpose_w(P.in[25] + (size_t)i * DM * UP, DM, UP, wl, DM, 1, smem);
    transpose_w(P.in[28] + (size_t)i * DFF * DM, DFF, DM, wl + W_UP, DFF, 0, smem);
    transpose_w(P.in[30] + (size_t)i * DM * DM, DM, DM, wl + W_UP + W_DOWN, DM, 0, smem);
    transpose_w(P.in[29] + (size_t)i * PLE * DM, PLE, DM, wl + W_UP + W_DOWN + W_GATE, PLE, 0, smem);
  }
  build_rotary(rot);
  grid.sync();

  bf16_t* hb = (bf16_t*)(ws + OFF_A);
  bf16_t* z1 = (bf16_t*)(ws + OFF_Z1);
  bf16_t* z2 = (bf16_t*)(ws + OFF_Z2);
  bf16_t* yab = (bf16_t*)(ws + OFF_Y);
  bf16_t* pb = (bf16_t*)(ws + OFF_Y);
  bf16_t* rkv = (bf16_t*)(ws + OFF_RKV);
  float* opart = (float*)(ws + OFF_RKV);
  float* lsep = (float*)(ws + OFF_LSE);
  bf16_t* Lb = (bf16_t*)(ws + OFF_L);
  bf16_t* gbuf = (bf16_t*)(ws + OFF_G);
  bf16_t* ea = (bf16_t*)(ws + OFF_Z2);
  bf16_t* ypb = (bf16_t*)(ws + OFF_YP);
  float* Qb = (float*)(ws + OFF_SQ);
  float* Mb = (float*)(ws + OFF_SM);
  float* Sib = (float*)(ws + OFF_SI);
  bf16_t* act = (bf16_t*)(ws + OFF_Z1);
  bf16_t* ub = (bf16_t*)(ws + OFF_Z1);
  bf16_t* db = (bf16_t*)(ws + OFF_Z2);
  bf16_t* ygb = (bf16_t*)(ws + OFF_RKV);

  for (int grp = 0; grp < 2; ++grp) {
    const int B = grp ? 16 : 2, S = grp ? 2048 : 16384;
    const float* xin = P.in[grp];
    const float* pin = P.in[2 + grp];
    float* xo = P.out + (size_t)grp * TG * DM;
    for (int layer = 0; layer < DEPTH; ++layer) {
      const int j = layer >> 1;
      const float* xcur = layer ? xo : xin;
      const bf16_t* wl = Wb + WOFF_LAYER + (size_t)layer * W_LAYER;
      ph_rmsnorm(xcur, P.in[21] + layer * DM, hb, TG, nullptr, nullptr);
      grid.sync();
      if ((layer & 1) == 0) {
        const bf16_t* we = Wb + WOFF_EVEN + (size_t)j * W_EVEN;
        ph_gemm_ab(hb, we, z1, z2, smem);
        grid.sync();
        ph_attention(z2, rot, opart, lsep, B, S, smem);
        grid.sync();
        ph_attn_combine(opart, lsep, yab);
        grid.sync();
        ph_rwkv_prep(z1, P.in[6] + j * RWKV_IN, rkv, Lb, S);
        grid.sync();
        ph_gemm_lora(Lb, we + W_AB + W_ABO, P.in[7] + j * 1024, P.in[9] + j * 1024, ea, gbuf, smem);
        grid.sync();
        ph_scan_pass1(rkv, ea, P.in[12] + j * RW, P.in[13] + j * RW, Qb, Mb, B, S, smem);
        grid.sync();
        ph_scan_pass2(Qb, Mb, Sib, B, S, smem);
        grid.sync();
        ph_scan_pass3(rkv, ea, P.in[12] + j * RW, P.in[13] + j * RW, Sib, ypb, B, S, smem);
        grid.sync();
        ph_rwkv_post(ypb, rkv, ea, gbuf, P.in[13] + j * RW, P.in[14] + j * RW, P.in[15] + j * RW, P.in[16] + j * RW, yab);
        grid.sync();
        ph_gemm_res(yab, AB_OUT, we + W_AB, xcur, xo, smem);
        grid.sync();
      } else {
        const bf16_t* wo = Wb + WOFF_ODD + (size_t)j * W_ODD;
        ph_gemm_bf16(hb, DM, DM, 0, wo, nullptr, ub, smem);
        grid.sync();
        ph_pool(ub, db, S);
        grid.sync();
        ph_gemm_bf16(db, DM, 256, 1, wo + W_CIN, P.in[19] + j * DM, ygb, smem);
        grid.sync();
        ph_gemm_res(ygb, DM, wo + W_CIN + W_GRP, xcur, xo, smem);
        grid.sync();
      }
      ph_rmsnorm(xo, P.in[22] + layer * DM, hb, TG, nullptr, nullptr);
      grid.sync();
      ph_ffn_up(hb, wl, P.in[26] + (size_t)layer * 3 * UP, P.in[27] + (size_t)layer * UP, act, B, S, smem);
      grid.sync();
      ph_gemm_res(act, DFF, wl + W_UP, xo, xo, smem);
      grid.sync();
      ph_rmsnorm(xo, P.in[23] + layer * DM, hb, TG, pin + (size_t)layer * TG * PLE, pb);
      grid.sync();
      ph_ple(hb, wl + W_UP + W_DOWN, P.in[31] + layer * DM, pb, wl + W_UP + W_DOWN + W_GATE, xo, smem);
      grid.sync();
    }
    ph_final_norm(xo, P.in[24], TG);
  }
}

extern "C" void kernel_launch(void* const* d_in, const int* in_sizes, int n_in, void* d_out, int out_size, void* d_ws, size_t ws_size, hipStream_t stream) {
  static int grid_blocks = 0;
  if (!grid_blocks) {
    int dev = 0, cus = 0, per_cu = 0;
    (void)hipGetDevice(&dev);
    (void)hipDeviceGetAttribute(&cus, hipDeviceAttributeMultiprocessorCount, dev);
    (void)hipFuncSetAttribute((const void*)mega, hipFuncAttributeMaxDynamicSharedMemorySize, SMEM_BYTES);
    (void)hipOccupancyMaxActiveBlocksPerMultiprocessor(&per_cu, (const void*)mega, 256, SMEM_BYTES);
    if (per_cu < 1) per_cu = 1;
    if (per_cu > 2) per_cu = 2;
    grid_blocks = cus * per_cu;
    if (ws_size < WS_NEED) fprintf(stderr, "kernel_launch: workspace too small: %zu < %zu\n", ws_size, (size_t)WS_NEED);
  }
  if (ws_size < WS_NEED || n_in != 32) return;
  Params p{};
  for (int i = 0; i < 32; ++i) p.in[i] = (const float*)d_in[i];
  p.out = (float*)d_out;
  p.ws = (char*)d_ws;
  void* args[] = {&p};
  hipError_t e = hipLaunchCooperativeKernel((const void*)mega, dim3(grid_blocks), dim3(256), args, SMEM_BYTES, stream);
  if (e != hipSuccess) fprintf(stderr, "cooperative launch failed: %s (grid %d)\n", hipGetErrorString(e), grid_blocks);
}
```

```cpp
#include <hip/hip_runtime.h>
#include <hip/hip_cooperative_groups.h>
#include <cstdio>
namespace cg = cooperative_groups;

typedef unsigned short bf16_t;
typedef short bf16x8 __attribute__((ext_vector_type(8)));
typedef float f32x4 __attribute__((ext_vector_type(4)));

constexpr int DM = 1024, DEPTH = 4, PLE = 256;
constexpr int RW = 512, RWKV_IN = 1920, ATT_IN = 2304, AB_IN = 4224, AB_OUT = 768;
constexpr int DFF = 2816, UP = 5632;
constexpr int TG = 32768;
constexpr int NLORA = 2560, KLORA = 384;
constexpr int CHUNK_L = 512;
constexpr int TB = 4;
constexpr int NT = 512, NW = 8;
constexpr int AB_PAD = 4352;

constexpr size_t W_AB = (size_t)AB_PAD * DM, W_ABO = (size_t)DM * AB_OUT, W_LORA = (size_t)NLORA * KLORA;
constexpr size_t W_EVEN = W_AB + W_ABO + W_LORA;
constexpr size_t W_CIN = (size_t)DM * DM, W_GRP = (size_t)DM * 256, W_COUT = (size_t)DM * DM;
constexpr size_t W_ODD = W_CIN + W_GRP + W_COUT;
constexpr size_t W_UP = (size_t)UP * DM, W_DOWN = (size_t)DM * DFF, W_GATE = (size_t)DM * DM, W_PROJ = (size_t)DM * PLE;
constexpr size_t W_LAYER = W_UP + W_DOWN + W_GATE + W_PROJ;
constexpr size_t WOFF_EVEN = 0, WOFF_ODD = 2 * W_EVEN, WOFF_LAYER = WOFF_ODD + 2 * W_ODD;
constexpr size_t W_TOTAL = WOFF_LAYER + 4 * W_LAYER;

constexpr size_t al256(size_t x) { return (x + 255) / 256 * 256; }
constexpr size_t OFF_W = 0;
constexpr size_t OFF_A = al256(W_TOTAL * 2);
constexpr size_t HB_HALO = (size_t)256 * DM * 2;
constexpr size_t SZ_A = (size_t)TG * DM * 2 + 2 * HB_HALO;
constexpr size_t OFF_Z1 = OFF_A + SZ_A;
constexpr size_t SZ_Z1 = (size_t)TG * RWKV_IN * 2;
constexpr size_t OFF_Z2 = OFF_Z1 + SZ_Z1;
constexpr size_t SZ_Z2 = (size_t)TG * ATT_IN * 2;
constexpr size_t OFF_Y = OFF_Z2 + SZ_Z2;
constexpr size_t SZ_Y = (size_t)TG * AB_OUT * 2;
constexpr size_t OFF_RKV = OFF_Y + SZ_Y;
constexpr size_t SZ_RKV = (size_t)TG * 1536 * 2;
constexpr size_t OFF_ROT = OFF_RKV + SZ_RKV;
constexpr size_t SZ_ROT = (size_t)16384 * 8 * 8;
constexpr size_t OFF_LSE = OFF_ROT + SZ_ROT;
constexpr size_t SZ_LSE = (size_t)3 * TG * 4 * 4;
constexpr size_t OFF_PS = OFF_LSE + SZ_LSE;
constexpr size_t SZ_PS = (size_t)3 * TG * 16 * 4;
constexpr size_t OFF_BAR = OFF_PS + SZ_PS;
constexpr size_t SZ_BAR = 3456 * 4;
constexpr size_t OFF_KN = OFF_BAR + al256(SZ_BAR);
constexpr size_t SZ_KN = (size_t)TG * 8 * 4;
constexpr size_t OFF_EDGE = OFF_KN + SZ_KN;
constexpr size_t SZ_EDGE = (size_t)(TG / 256) * 4 * UP * 2;
constexpr size_t WS_NEED = OFF_EDGE + SZ_EDGE;
constexpr size_t OFF_L = OFF_A;
constexpr size_t OFF_G = OFF_A + al256((size_t)TG * KLORA * 2);
constexpr size_t OFF_YP = OFF_Z1;
constexpr size_t OFF_SQ = OFF_Z1 + (size_t)2 * TG * RW * 2;
constexpr size_t OFF_SM = OFF_SQ + (size_t)1024 * 4096 * 4;
constexpr size_t OFF_SI = OFF_SM + (size_t)1024 * 4096 * 4;
static_assert(OFF_SI + (size_t)1024 * 4096 * 4 <= OFF_Z2, "scan states overflow Z1");
static_assert((size_t)TG * KLORA * 2 + (size_t)TG * RW * 2 + 256 <= SZ_A - HB_HALO, "L+g overflow A");
static_assert((size_t)3 * TG * 256 * 4 <= SZ_RKV, "o_part overflow");

struct Params { const float* in[32]; float* out; char* ws; };

__device__ __forceinline__ bf16_t f2bf(float f) {
  unsigned u = __float_as_uint(f);
  u += 0x7fffu + ((u >> 16) & 1u);
  return (bf16_t)(u >> 16);
}
__device__ __forceinline__ float bf2f(bf16_t h) { return __uint_as_float(((unsigned)h) << 16); }
__device__ __forceinline__ unsigned pack2(float a, float b) { return (unsigned)f2bf(a) | ((unsigned)f2bf(b) << 16); }
__device__ __forceinline__ float lo2f(unsigned u) { return __uint_as_float(u << 16); }
__device__ __forceinline__ float hi2f(unsigned u) { return __uint_as_float(u & 0xffff0000u); }
__device__ __forceinline__ void unpack8(const uint4& u, float (&f)[8]) {
  f[0] = lo2f(u.x); f[1] = hi2f(u.x); f[2] = lo2f(u.y); f[3] = hi2f(u.y); f[4] = lo2f(u.z); f[5] = hi2f(u.z); f[6] = lo2f(u.w); f[7] = hi2f(u.w);
}
__device__ __forceinline__ int tid_from_wave(int wv) { unsigned z = 0; asm volatile("" : "+v"(z));   int t = wv * 64 + (int)__builtin_amdgcn_mbcnt_hi(~0u, __builtin_amdgcn_mbcnt_lo(~0u, z)); return t; }
#define tid_opaque() tid_from_wave(g_wv)
__device__ __forceinline__ float wave_sum(float v) {
#pragma unroll
  for (int o = 32; o > 0; o >>= 1) v += __shfl_xor(v, o, 64);
  return v;
}
__device__ __forceinline__ float sigmoidf_(float x) { return 1.0f / (1.0f + __expf(-x)); }
__device__ __forceinline__ float tanhf_(float x) {
  float ax = fabsf(x);
  float e = __expf(-2.0f * ax);
  float t = (1.0f - e) / (1.0f + e);
  return x < 0.f ? -t : t;
}
__device__ __forceinline__ float gelu_tanh(float x) {
  float y = 0.7978845608028654f * (x + 0.044715f * x * x * x);
  return 0.5f * x * (1.0f + tanhf_(y));
}

__device__ __forceinline__ void transpose_w(int g_wv, const float* __restrict__ src, int K, int N, bf16_t* __restrict__ dst, int ldk, int mode, char* smem) {
  float* tile = (float*)smem;
  const int tid = tid_opaque();
  const int tk = K / 64, tn = N / 64;
  for (int t = blockIdx.x; t < tk * tn; t += gridDim.x) {
    int k0 = (t / tn) * 64, n0 = (t % tn) * 64;
    __syncthreads();
    if (tid < 256) {
#pragma unroll
    for (int i = 0; i < 4; ++i) {
      int r = (tid >> 4) + 16 * i, c4 = (tid & 15) * 4;
      float4 v = *(const float4*)(src + (size_t)(k0 + r) * N + n0 + c4);
      tile[r * 65 + c4 + 0] = v.x; tile[r * 65 + c4 + 1] = v.y; tile[r * 65 + c4 + 2] = v.z; tile[r * 65 + c4 + 3] = v.w;
    }
    }
    __syncthreads();
    if (tid >= 256) continue;
    int nl = tid >> 2, ks = (tid & 3) * 16;
    int n = n0 + nl;
    int drow = n;
    if (mode == 1) { int c = (n < DFF) ? n : n - DFF; drow = (c >> 7) * 256 + ((n < DFF) ? 0 : 128) + (c & 127); }
    unsigned o[8];
#pragma unroll
    for (int j = 0; j < 8; ++j) o[j] = pack2(tile[(ks + 2 * j) * 65 + nl], tile[(ks + 2 * j + 1) * 65 + nl]);
    uint4* dp = (uint4*)(dst + (size_t)drow * ldk + k0 + ks);
    dp[0] = make_uint4(o[0], o[1], o[2], o[3]);
    dp[1] = make_uint4(o[4], o[5], o[6], o[7]);
  }
}

__device__ __forceinline__ void build_lora(int g_wv, const float* __restrict__ w_up, const float* __restrict__ a_up, const float* __restrict__ g_up, bf16_t* __restrict__ dst) {
  const int total = NLORA * 256;
  for (int e = blockIdx.x * NT + tid_opaque(); e < total; e += gridDim.x * NT) {
    int k = e / NLORA, n = e - k * NLORA;
    int nb = n >> 9, nl = n & 511;
    float v = 0.f;
    if (nb < 2) { int kk = k - 64 * nb; if (kk >= 0 && kk < 64) v = w_up[((size_t)nb * 64 + kk) * 512 + nl]; }
    else if (nb < 4) { int d = nb - 2; int kk = k - 128 - 64 * d; if (kk >= 0 && kk < 64) v = a_up[((size_t)d * 64 + kk) * 512 + nl]; }
    else { int kk = k - 128; if (kk >= 0 && kk < 128) v = g_up[(size_t)kk * 512 + nl]; }
    dst[(size_t)n * 256 + k] = f2bf(v);
  }
}

__device__ __forceinline__ void build_rotary(int g_wv, float2* __restrict__ rot) {
  const float invf[8] = {1.0f, 0.1939227432012558f, 0.03760603070259094f, 0.007292664609849453f, 0.0014142135623842478f,
                         0.00027424818836152554f, 5.318296098266728e-05f, 1.0313386155758053e-05f};
  for (int e = blockIdx.x * NT + tid_opaque(); e < 16384 * 8; e += gridDim.x * NT) {
    int s = e >> 3, i = e & 7;
    float inv = invf[0];
#pragma unroll
    for (int q = 1; q < 8; ++q) inv = (i == q) ? invf[q] : inv;
    float angf = (float)s * inv;
    double a = (double)angf;
    double rev = a * 0.15915494309189535;
    rev -= rint(rev);
    double x = rev * 6.283185307179586;
    double x2 = x * x;
    double sn = 0.0, cs = 0.0;
    {
      double t = 1.0; cs = 1.0;
#pragma unroll
      for (int n = 1; n <= 13; ++n) { t = -t * x2 / (double)((2 * n - 1) * (2 * n)); cs += t; }
      double u = x; sn = x;
#pragma unroll
      for (int n = 1; n <= 13; ++n) { u = -u * x2 / (double)((2 * n) * (2 * n + 1)); sn += u; }
    }
    rot[e] = make_float2((float)cs, (float)sn);
  }
}

__device__ __forceinline__ void ph_rmsnorm(int g_wv, const float* __restrict__ x, const float* __restrict__ g, bf16_t* __restrict__ hb, int T,
                           const float* __restrict__ p, bf16_t* __restrict__ pb, bool zero_halo = false) {
  const int lane = tid_opaque() & 63, wv = __builtin_amdgcn_readfirstlane(tid_opaque() >> 6);
  if (zero_halo) {
    for (int e = blockIdx.x * NT + tid_opaque(); e < 257 * (DM / 8); e += gridDim.x * NT) {
      int r = e / (DM / 8), c = (e - r * (DM / 8)) * 8;
      long row = (r == 0) ? -1 : (long)T + r - 1;
      unsigned z = 0; asm volatile("" : "+v"(z));
      *(uint4*)(hb + row * DM + c) = make_uint4(z, z, z, z);
    }
  }
  float4 gv[4];
#pragma unroll
  for (int i = 0; i < 4; ++i) gv[i] = *(const float4*)(g + 4 * lane + 256 * i);
  for (int row = blockIdx.x * NW + wv; row < T; row += gridDim.x * NW) {
    const float* xr = x + (size_t)row * DM;
    float4 v[4];
    float ss = 0.f;
#pragma unroll
    for (int i = 0; i < 4; ++i) { v[i] = *(const float4*)(xr + 4 * lane + 256 * i); ss += v[i].x * v[i].x + v[i].y * v[i].y + v[i].z * v[i].z + v[i].w * v[i].w; }
    ss = wave_sum(ss);
    float rs = rsqrtf(ss * (1.0f / DM) + 1e-6f);
#pragma unroll
    for (int i = 0; i < 4; ++i) {
      uint2 o;
      o.x = pack2(v[i].x * rs * gv[i].x, v[i].y * rs * gv[i].y);
      o.y = pack2(v[i].z * rs * gv[i].z, v[i].w * rs * gv[i].w);
      *(uint2*)(hb + (size_t)row * DM + 4 * lane + 256 * i) = o;
    }
    if (p) {
      float4 pv = *(const float4*)(p + (size_t)row * PLE + 4 * lane);
      uint2 o; o.x = pack2(pv.x, pv.y); o.y = pack2(pv.z, pv.w);
      *(uint2*)(pb + (size_t)row * PLE + 4 * lane) = o;
    }
  }
}
__device__ __forceinline__ void zero_hb_halo(int g_wv, bf16_t* hb, int T) {
  for (int e = blockIdx.x * NT + tid_opaque(); e < 257 * (DM / 8); e += gridDim.x * NT) {
    int r = e / (DM / 8), c = (e - r * (DM / 8)) * 8;
    long row = (r == 0) ? -1 : (long)T + r - 1;
    unsigned z = 0; asm volatile("" : "+v"(z));
    *(uint4*)(hb + row * DM + c) = make_uint4(z, z, z, z);
  }
}
__device__ __forceinline__ void ph_final_norm(int g_wv, float* __restrict__ x, const float* __restrict__ g, int T) {
  const int lane = tid_opaque() & 63, wv = __builtin_amdgcn_readfirstlane(tid_opaque() >> 6);
  for (int row = blockIdx.x * NW + wv; row < T; row += gridDim.x * NW) {
    float* xr = x + (size_t)row * DM;
    float4 v[4];
    float ss = 0.f;
#pragma unroll
    for (int i = 0; i < 4; ++i) { v[i] = *(const float4*)(xr + 4 * lane + 256 * i); ss += v[i].x * v[i].x + v[i].y * v[i].y + v[i].z * v[i].z + v[i].w * v[i].w; }
    ss = wave_sum(ss);
    float rs = rsqrtf(ss * (1.0f / DM) + 1e-6f);
#pragma unroll
    for (int i = 0; i < 4; ++i) {
      float4 gg = *(const float4*)(g + 4 * lane + 256 * i);
      float4 o = make_float4(v[i].x * rs * gg.x, v[i].y * rs * gg.y, v[i].z * rs * gg.z, v[i].w * rs * gg.w);
      *(float4*)(xr + 4 * lane + 256 * i) = o;
    }
  }
}

#define PG8_LAS __attribute__((address_space(3)))
constexpr int BK = 64, HALF = 128, HTB = HALF * BK * 2, SMEM_BYTES = 8 * HTB;
__device__ __forceinline__ int lds_byte(int r, int c) { const int st = (r >> 4) * 2 + (c >> 5), rr = r & 15, cc = c & 31, ob = rr * 64 + cc * 2; return st * 1024 + (ob ^ (((ob >> 9) & 1) << 5)); }
__device__ __forceinline__ void stage_rc(int b, int& R, int& C) { const int st = b / 1024, sb = b % 1024, swz = sb ^ (((sb >> 9) & 1) << 5); R = (st >> 1) * 16 + swz / 64; C = (st & 1) * 32 + (swz % 64) / 2; }
struct Unit { int pm, pn; long aoff; };
struct Gemm { const bf16_t* A; const bf16_t* Bt; int lda; int K; };

__device__ __forceinline__ int tile_remap(int t, int ntiles) {
  int G = gridDim.x;
  int it = t / G;
  if ((G & 7) == 0 && (it + 1) * G <= ntiles) {
    int b = t - it * G;
    return it * G + (b & 7) * (G >> 3) + (b >> 3);
  }
  return t;
}
__device__ __forceinline__ void tile_map(int t0, int nt_m, int nt_n, int bw, int& tm, int& tn) {
  asm volatile("" : "+s"(nt_m), "+s"(nt_n), "+s"(bw));
  int lt = tile_remap(t0, nt_m * nt_n);
  int full = nt_m * bw;
  int nr = (nt_n + bw - 1) / bw;
  int r = lt / full;
  if (r > nr - 1) r = nr - 1;
  int rem = lt - r * full;
  int width = (r == nr - 1) ? (nt_n - r * bw) : bw;
  tm = rem / width;
  tn = r * bw + (rem - tm * width);
}
struct TileSched {
  int nt_m, nt_n, bw, lda, rowstep, rowoff, acolstep, acol_from, acol_add;
  __device__ __forceinline__ void fill(int t0, Unit& u) const {
    int tm, tn; tile_map(t0, nt_m, nt_n, bw, tm, tn);
    u.pm = tm; u.pn = tn;
    u.aoff = (((long)tm * rowstep + rowoff) * lda + (long)tn * acolstep + ((acol_add && tn >= acol_from) ? acol_add : 0)) * 2;
  }
  __device__ __forceinline__ bool next(int i, Unit& u) const {
    const int t0 = blockIdx.x + i * gridDim.x;
    if (t0 >= nt_m * nt_n) return false;
    fill(t0, u);
    return true;
  }
};
struct OneUnit {
  Unit u;
  __device__ __forceinline__ bool next(int i, Unit& o) const { if (i) return false; o = u; return true; }
};

template <class Epi, class Sched>
__device__ __forceinline__ void gemm_phase(int g_wv, PG8_LAS unsigned char* lds, const Gemm g, const Sched& S, const Epi& E) {
  const int tid = tid_opaque(), wid = __builtin_amdgcn_readfirstlane(tid >> 6), lane = tid & 63, wr = wid >> 2, wc = wid & 3, fr = lane & 15, fq = lane >> 4;
  const int K = g.K, nt = K / BK;
  unsigned voffA[2], voffB[2];
#pragma unroll
  for (int i = 0; i < 2; ++i) { int R, C; stage_rc(tid * 16 + i * 8192, R, C); voffA[i] = (unsigned)(R * g.lda + C) * 2u; voffB[i] = (unsigned)(R * K + C) * 2u; }
  const size_t kstep = (size_t)(BK * 2);
  const size_t hstepA = (size_t)HALF * g.lda * 2, hstepB = (size_t)HALF * K * 2;
  const size_t tstepB = 2 * hstepB;
  const unsigned ldsw = (unsigned)wid * 1024u;
  const int aoff = lds_byte(wr * 64 + fr, fq * 8), boff = lds_byte(wc * 32 + fr, fq * 8);
#define PG8_SA(b, h) (((b) * 2 + (h)) * HTB)
#define PG8_SB(b, h) ((4 + (b) * 2 + (h)) * HTB)
#define PG8_STAGE(bufoff, gbase, voff) do { _Pragma("unroll") for (int _i = 0; _i < 2; ++_i) \
    __builtin_amdgcn_global_load_lds((const unsigned*)((const char*)(gbase) + (voff)[_i]), (PG8_LAS unsigned*)(lds + (bufoff) + ldsw + _i * 8192), 16, 0, 0); } while (0)
#define PG8_LDA(dst, b, h) do { _Pragma("unroll") for (int m = 0; m < 4; ++m) _Pragma("unroll") for (int k = 0; k < 2; ++k) dst[m][k] = *(const PG8_LAS bf16x8*)(lds + PG8_SA(b, h) + aoff + m * 2048 + k * 1024); } while (0)
#define PG8_LDB(dst, b, h) do { _Pragma("unroll") for (int n = 0; n < 2; ++n) _Pragma("unroll") for (int k = 0; k < 2; ++k) dst[n][k] = *(const PG8_LAS bf16x8*)(lds + PG8_SB(b, h) + boff + n * 2048 + k * 1024); } while (0)
#define PG8_MMA(ai, bj, At, Bt) do { __builtin_amdgcn_s_setprio(1); _Pragma("unroll") for (int m = 0; m < 4; ++m) _Pragma("unroll") for (int n = 0; n < 2; ++n) _Pragma("unroll") for (int k = 0; k < 2; ++k) \
    acc[ai][bj][m][n] = __builtin_amdgcn_mfma_f32_16x16x32_bf16(Bt[n][k], At[m][k], acc[ai][bj][m][n], 0, 0, 0); __builtin_amdgcn_s_setprio(0); } while (0)
#define PG8_WAIT_V(n) asm volatile("s_waitcnt vmcnt(" #n ")" ::: "memory")
#define PG8_WAIT_L(n) asm volatile("s_waitcnt lgkmcnt(" #n ")" ::: "memory")
#define PG8_BAR __builtin_amdgcn_s_barrier()
#define PG8_SCHED __builtin_amdgcn_sched_barrier(0)
  Unit cur, nxt; int ui = 0;
  if (!S.next(0, cur)) return;
  f32x4 acc[2][2][4][2];
#pragma unroll
  for (int a = 0; a < 2; ++a)
#pragma unroll
    for (int b = 0; b < 2; ++b)
#pragma unroll
      for (int m = 0; m < 4; ++m)
#pragma unroll
        for (int n = 0; n < 2; ++n) acc[a][b][m][n] = (f32x4){0.f, 0.f, 0.f, 0.f};
  bf16x8 At[4][2], B0[2][2], B1[2][2];
  const char* cA = (const char*)g.A + cur.aoff; const char* cB = (const char*)g.Bt + (size_t)cur.pn * tstepB;
  PG8_STAGE(PG8_SB(0, 0), cB, voffB); PG8_STAGE(PG8_SA(0, 0), cA, voffA); PG8_STAGE(PG8_SB(0, 1), cB + hstepB, voffB); PG8_STAGE(PG8_SA(0, 1), cA + hstepA, voffA);
  if (wr == 1) PG8_BAR;
  PG8_WAIT_V(4); PG8_BAR;
  PG8_STAGE(PG8_SB(1, 0), cB + kstep, voffB); PG8_STAGE(PG8_SA(1, 0), cA + kstep, voffA); PG8_STAGE(PG8_SB(1, 1), cB + hstepB + kstep, voffB);
  PG8_WAIT_V(6); PG8_BAR;
  for (;;) {
    const bool has_next = S.next(ui + 1, nxt);
    const char* nA = has_next ? (const char*)g.A + nxt.aoff : cA; const char* nB = has_next ? (const char*)g.Bt + (size_t)nxt.pn * tstepB : cB;
#pragma unroll 1
    for (int t = 0; t < nt; t += 2) {
      const bool last = (t == nt - 2);
      const char* a1 = cA + (size_t)(t + 1) * kstep;
      const char* a2 = last ? nA : cA + (size_t)(t + 2) * kstep; const char* b2 = last ? nB : cB + (size_t)(t + 2) * kstep;
      const char* a3 = a2 + kstep; const char* b3 = b2 + kstep;
      PG8_LDB(B0, 0, 0); PG8_SCHED; PG8_LDA(At, 0, 0); PG8_STAGE(PG8_SA(1, 1), a1 + hstepA, voffA);
      PG8_WAIT_L(8); PG8_BAR; PG8_WAIT_L(0); PG8_MMA(0, 0, At, B0); PG8_BAR; PG8_SCHED;
      PG8_LDB(B1, 0, 1); PG8_STAGE(PG8_SB(0, 0), b2, voffB);
      PG8_BAR; PG8_WAIT_L(0); PG8_MMA(0, 1, At, B1); PG8_BAR;
      PG8_LDA(At, 0, 1); PG8_STAGE(PG8_SA(0, 0), a2, voffA);
      PG8_BAR; PG8_WAIT_L(0); PG8_MMA(1, 0, At, B0); PG8_BAR; PG8_SCHED;
      PG8_STAGE(PG8_SB(0, 1), b2 + hstepB, voffB);
      PG8_WAIT_V(6); PG8_BAR; PG8_MMA(1, 1, At, B1); PG8_BAR;
      PG8_LDB(B0, 1, 0); PG8_SCHED; PG8_LDA(At, 1, 0); PG8_STAGE(PG8_SA(0, 1), a2 + hstepA, voffA);
      PG8_WAIT_L(8); PG8_BAR; PG8_WAIT_L(0); PG8_MMA(0, 0, At, B0); PG8_BAR; PG8_SCHED;
      PG8_LDB(B1, 1, 1); PG8_STAGE(PG8_SB(1, 0), b3, voffB);
      PG8_BAR; PG8_WAIT_L(0); PG8_MMA(0, 1, At, B1); PG8_BAR;
      PG8_LDA(At, 1, 1); PG8_STAGE(PG8_SA(1, 0), a3, voffA);
      PG8_BAR; PG8_WAIT_L(0); PG8_MMA(1, 0, At, B0); PG8_BAR; PG8_SCHED;
      PG8_STAGE(PG8_SB(1, 1), b3 + hstepB, voffB);
      PG8_WAIT_V(6); PG8_BAR; PG8_MMA(1, 1, At, B1); PG8_BAR;
    }
    if constexpr (!Epi::AFTER_DRAIN) E(acc, cur, wr, wc, fr, fq);
    if (!has_next) break;
#pragma unroll
    for (int a = 0; a < 2; ++a)
#pragma unroll
      for (int b = 0; b < 2; ++b)
#pragma unroll
        for (int m = 0; m < 4; ++m)
#pragma unroll
          for (int n = 0; n < 2; ++n) acc[a][b][m][n] = (f32x4){0.f, 0.f, 0.f, 0.f};
    cur = nxt; cA = nA; cB = nB; ++ui;
  }
  PG8_WAIT_V(0);
  if (wr == 0) PG8_BAR;
  PG8_BAR;
  if constexpr (Epi::AFTER_DRAIN) E.fused(acc, cur, wr, wc, fr, fq, lds, wid, lane);
#undef PG8_SA
#undef PG8_SB
#undef PG8_STAGE
#undef PG8_LDA
#undef PG8_LDB
#undef PG8_MMA
#undef PG8_WAIT_V
#undef PG8_WAIT_L
#undef PG8_BAR
#undef PG8_SCHED
}

#define EPI_ROWS _Pragma("unroll") for (int ai = 0; ai < 2; ++ai) _Pragma("unroll") for (int m = 0; m < 4; ++m)
#define EPI_COLS _Pragma("unroll") for (int bj = 0; bj < 2; ++bj) _Pragma("unroll") for (int n = 0; n < 2; ++n)
#define EPI_FENCE __builtin_amdgcn_sched_barrier(0)
#define EPI_FOR  EPI_ROWS EPI_COLS
#define EPI_ROW (128 * ai + 64 * wr + 16 * m + fr)
#define EPI_COL (128 * bj + 32 * wc + 16 * n + 4 * fq)

__device__ __forceinline__ float row_rstd(const float* __restrict__ ps, size_t row) {
  const float4* p4 = (const float4*)(ps + row * 16);
  float4 a = p4[0], b = p4[1], c = p4[2], d = p4[3];
  float sm = ((a.x + a.y) + (a.z + a.w)) + ((b.x + b.y) + (b.z + b.w)) + ((c.x + c.y) + (c.z + c.w)) + ((d.x + d.y) + (d.z + d.w));
  return rsqrtf(sm * (1.0f / DM) + 1e-6f);
}
#define EPI_LANE(ld, es) ((unsigned)(((64 * wr + fr) * (ld) + 32 * wc + 4 * fq) * (es)))
#define EPI_CONST(ld, es) ((unsigned)(((128 * ai + 16 * m) * (ld) + 128 * bj + 16 * n) * (es)))

#define RS_DECL(psptr, rowbase) float4 rq0 = make_float4(0.f, 0.f, 0.f, 0.f), rq1 = rq0, rq2 = rq0, rq3 = rq0; \
  if (psptr) { const float4* p4_ = (const float4*)((psptr) + ((rowbase) + 64 * wr + fr) * 16); rq0 = p4_[0]; rq1 = p4_[1]; rq2 = p4_[2]; rq3 = p4_[3]; }
#define RS_TAKE(psptr, rowbase) \
  const float rs = (psptr) ? rsqrtf((((rq0.x + rq0.y) + (rq0.z + rq0.w)) + ((rq1.x + rq1.y) + (rq1.z + rq1.w)) + ((rq2.x + rq2.y) + (rq2.z + rq2.w)) + ((rq3.x + rq3.y) + (rq3.z + rq3.w))) * (1.0f / DM) + 1e-6f) : 1.0f; \
  if ((psptr) && !(ai == 1 && m == 3)) { const int nr_ = (m == 3) ? 128 : (128 * ai + 16 * (m + 1)); \
    const float4* p4_ = (const float4*)((psptr) + ((rowbase) + nr_ + 64 * wr + fr) * 16); rq0 = p4_[0]; rq1 = p4_[1]; rq2 = p4_[2]; rq3 = p4_[3]; }

struct EpiAB {
  static constexpr bool AFTER_DRAIN = false;
  bf16_t* z1; bf16_t* z2; const float* ps;
  __device__ __forceinline__ void operator()(const f32x4 (&acc)[2][2][4][2], const Unit& u, int wr, int wc, int fr, int fq) const {
    EPI_FENCE;
    asm volatile("" : "+v"(fr), "+v"(fq));
    char* b1 = (char*)(z1 + (size_t)u.pm * 256 * RWKV_IN + u.pn * 256);
    char* b2 = (char*)(z2 + (size_t)u.pm * 256 * ATT_IN + u.pn * 256 - RWKV_IN);
    const unsigned l1 = EPI_LANE(RWKV_IN, 2), l2 = EPI_LANE(ATT_IN, 2);
    const int ncl = u.pn * 256 + 32 * wc + 4 * fq;
    RS_DECL(ps, (size_t)u.pm * 256)
    EPI_ROWS {
      RS_TAKE(ps, (size_t)u.pm * 256)
      EPI_COLS {
        const int nc = ncl + 128 * bj + 16 * n;
        const f32x4 v = acc[ai][bj][m][n] * rs;
        uint2 o; o.x = pack2(v[0], v[1]); o.y = pack2(v[2], v[3]);
        if (nc < RWKV_IN) *(uint2*)(b1 + (l1 + EPI_CONST(RWKV_IN, 2))) = o;
        else if (nc < AB_IN) *(uint2*)(b2 + (l2 + EPI_CONST(ATT_IN, 2))) = o;
      }
      EPI_FENCE;
    }
  }
};
__device__ __forceinline__ void ph_gemm_ab(int g_wv, const bf16_t* __restrict__ hb, const bf16_t* __restrict__ W, bf16_t* __restrict__ z1, bf16_t* __restrict__ z2, const float* ps, char* smem) {
  TileSched S{TG / 256, AB_PAD / 256, 4, DM, 256, 0, 0};
  gemm_phase(g_wv, (PG8_LAS unsigned char*)smem, Gemm{hb, W, DM, DM}, S, EpiAB{z1, z2, ps});
}

struct EpiLora {
  static constexpr bool AFTER_DRAIN = false;
  const float* w0; const float* a0; bf16_t* ea; bf16_t* gb;
  template <int MODE>
  __device__ __forceinline__ void run(const f32x4 (&acc)[2][2][4][2], const Unit& u, int wr, int wc, int fr, int fq) const {
    const int tn = u.pn;
    const int ncl = tn * 256 + 32 * wc + 4 * fq;
    const float* bp = (MODE == 0) ? (w0 + ncl) : (a0 + ncl - 1024);
    float4 bv[2][2];
    EPI_COLS { bv[bj][n] = (MODE < 2) ? *(const float4*)(bp + 128 * bj + 16 * n) : make_float4(0.f, 0.f, 0.f, 0.f); }
    char* bo = (MODE < 2) ? (char*)(ea + (size_t)u.pm * 256 * 2048 + tn * 256) : (char*)(gb + (size_t)u.pm * 256 * RW + tn * 256 - 2048);
    const unsigned lo = (MODE < 2) ? EPI_LANE(2048, 2) : EPI_LANE(RW, 2);
    EPI_ROWS {
      EPI_COLS {
        const f32x4 v = acc[ai][bj][m][n];
        const float4 b = bv[bj][n];
        float o0, o1, o2, o3;
        if (MODE == 0) {
          o0 = 0.60653066f * sigmoidf_(v[0] + b.x); o1 = 0.60653066f * sigmoidf_(v[1] + b.y);
          o2 = 0.60653066f * sigmoidf_(v[2] + b.z); o3 = 0.60653066f * sigmoidf_(v[3] + b.w);
        } else if (MODE == 1) {
          o0 = sigmoidf_(v[0] + b.x); o1 = sigmoidf_(v[1] + b.y); o2 = sigmoidf_(v[2] + b.z); o3 = sigmoidf_(v[3] + b.w);
        } else { o0 = v[0]; o1 = v[1]; o2 = v[2]; o3 = v[3]; }
        uint2 o; o.x = pack2(o0, o1); o.y = pack2(o2, o3);
        *(uint2*)(bo + (lo + ((MODE < 2) ? EPI_CONST(2048, 2) : EPI_CONST(RW, 2)))) = o;
        EPI_FENCE;
      }
    }
  }
  __device__ __forceinline__ void operator()(const f32x4 (&acc)[2][2][4][2], const Unit& u, int wr, int wc, int fr, int fq) const {
    EPI_FENCE;
    asm volatile("" : "+v"(fr), "+v"(fq));
    if (u.pn < 4) run<0>(acc, u, wr, wc, fr, fq);
    else if (u.pn < 8) run<1>(acc, u, wr, wc, fr, fq);
    else run<2>(acc, u, wr, wc, fr, fq);
  }
};
__device__ __forceinline__ void ph_gemm_lora(int g_wv, const bf16_t* __restrict__ L, const bf16_t* __restrict__ W, const float* __restrict__ w0, const float* __restrict__ a0,
                             bf16_t* __restrict__ ea, bf16_t* __restrict__ gb, char* smem) {
  TileSched S{TG / 256, NLORA / 256, 10, KLORA, 256, 0, 0, 8, 128};
  gemm_phase(g_wv, (PG8_LAS unsigned char*)smem, Gemm{L, W, KLORA, 256}, S, EpiLora{w0, a0, ea, gb});
}

struct EpiRes {
  static constexpr bool AFTER_DRAIN = false;
  const float* xsrc; float* xdst;
  const float* gn; bf16_t* xg; float* ps;
  __device__ __forceinline__ void operator()(const f32x4 (&acc)[2][2][4][2], const Unit& u, int wr, int wc, int fr, int fq) const {
    EPI_FENCE;
    asm volatile("" : "+v"(fr), "+v"(fq));
    const size_t tb = ((size_t)u.pm * 256 * DM + u.pn * 256) * 4;
    const char* bs = (const char*)xsrc + tb; char* bd = (char*)xdst + tb;
    char* bg2 = (char*)xg + tb / 2;
    const float* gp = gn + u.pn * 256 + 32 * wc + 4 * fq;
    const unsigned lo = EPI_LANE(DM, 4);
#pragma unroll
    for (int ai = 0; ai < 2; ++ai) {
      float4 xs[4][2][2];
#pragma unroll
      for (int m = 0; m < 4; ++m) { EPI_COLS { xs[m][bj][n] = *(const float4*)(bs + (lo + EPI_CONST(DM, 4))); } }
      EPI_FENCE;
#pragma unroll
      for (int m = 0; m < 4; ++m) {
        float ssq = 0.f;
        EPI_COLS {
          const f32x4 v = acc[ai][bj][m][n]; const float4 x4 = xs[m][bj][n];
          const float4 o = make_float4(x4.x + v[0], x4.y + v[1], x4.z + v[2], x4.w + v[3]);
          *(float4*)(bd + (lo + EPI_CONST(DM, 4))) = o;
          if (xg) {
            const float4 g4 = *(const float4*)(gp + 128 * bj + 16 * n);
            uint2 q; q.x = pack2(o.x * g4.x, o.y * g4.y); q.y = pack2(o.z * g4.z, o.w * g4.w);
            *(uint2*)(bg2 + (lo + EPI_CONST(DM, 4)) / 2) = q;
            ssq += (o.x * o.x + o.y * o.y) + (o.z * o.z + o.w * o.w);
          }
        }
        if (xg) {
          ssq += __shfl_xor(ssq, 16, 64);
          ssq += __shfl_xor(ssq, 32, 64);
          if (fq == 0) ps[((size_t)u.pm * 256 + EPI_ROW) * 16 + u.pn * 4 + wc] = ssq;
        }
        EPI_FENCE;
      }
    }
  }
};
__device__ __forceinline__ void ph_gemm_res(int g_wv, const bf16_t* __restrict__ A, int K, const bf16_t* __restrict__ W, const float* xsrc, float* xdst,
                                            const float* gn, bf16_t* xg, float* ps, char* smem) {
  TileSched S{TG / 256, DM / 256, 4, K, 256, 0, 0};
  gemm_phase(g_wv, (PG8_LAS unsigned char*)smem, Gemm{A, W, K, K}, S, EpiRes{xsrc, xdst, gn, xg, ps});
}

template <bool HAS_SCALE> struct EpiBf16 {
  static constexpr bool AFTER_DRAIN = false;
  const float* scale; bf16_t* out; const float* ps;
  __device__ __forceinline__ void operator()(const f32x4 (&acc)[2][2][4][2], const Unit& u, int wr, int wc, int fr, int fq) const {
    EPI_FENCE;
    asm volatile("" : "+v"(fr), "+v"(fq));
    const float* sp = scale + (HAS_SCALE ? (u.pn * 256 + 32 * wc + 4 * fq) : 0);
    float4 sv[2][2];
    EPI_COLS { sv[bj][n] = HAS_SCALE ? *(const float4*)(sp + 128 * bj + 16 * n) : make_float4(1.f, 1.f, 1.f, 1.f); }
    char* bo = (char*)(out + (size_t)u.pm * 256 * DM + u.pn * 256);
    const unsigned lo = EPI_LANE(DM, 2);
    RS_DECL(ps, (size_t)u.pm * 256)
    EPI_ROWS {
      RS_TAKE(ps, (size_t)u.pm * 256)
      EPI_COLS {
        const f32x4 v = acc[ai][bj][m][n] * rs;
        uint2 o;
        if (HAS_SCALE) { const float4 s = sv[bj][n]; o.x = pack2(v[0] * s.x, v[1] * s.y); o.y = pack2(v[2] * s.z, v[3] * s.w); } else { o.x = pack2(v[0], v[1]); o.y = pack2(v[2], v[3]); }
        *(uint2*)(bo + (lo + EPI_CONST(DM, 2))) = o;
        EPI_FENCE;
      }
    }
  }
};
__device__ __forceinline__ void ph_gemm_bf16(int g_wv, const bf16_t* __restrict__ A, int lda, int K, int grouped, const bf16_t* __restrict__ W, const float* __restrict__ scale,
                             bf16_t* __restrict__ out, const float* ps, char* smem) {
  TileSched S{TG / 256, DM / 256, 4, lda, 256, 0, grouped ? 256 : 0};
  if (scale) gemm_phase(g_wv, (PG8_LAS unsigned char*)smem, Gemm{A, W, lda, K}, S, EpiBf16<true>{scale, out, ps});
  else gemm_phase(g_wv, (PG8_LAS unsigned char*)smem, Gemm{A, W, lda, K}, S, EpiBf16<false>{scale, out, ps});
}

struct EpiFFN {
  static constexpr bool AFTER_DRAIN = true;
  const float* cw; const float* cb; bf16_t* act; int S; const float* ps; bf16_t* edge;
  __device__ __forceinline__ void operator()(const f32x4 (&)[2][2][4][2], const Unit&, int, int, int, int) const {}
  __device__ __forceinline__ void fused(f32x4 (&acc)[2][2][4][2], const Unit& u, int wr, int wc, int fr, int fq, PG8_LAS unsigned char* ldsp, int wid, int lane) const {
    char* U = (char*)ldsp;
    const int tid = wid * 64 + lane;
    const int s0 = u.pm * 256, tn = u.pn;
#pragma unroll
    for (int ai = 0; ai < 2; ++ai)
#pragma unroll
      for (int m = 0; m < 4; ++m) {
        const int row = EPI_ROW;
        const int grow = s0 + row;
        const float rs = (grow >= 0 && grow < TG) ? row_rstd(ps, (size_t)grow) : 0.f;
#pragma unroll
        for (int bj = 0; bj < 2; ++bj)
#pragma unroll
          for (int n = 0; n < 2; ++n) {
            const f32x4 v = acc[ai][bj][m][n] * rs;
            const int col = 128 * bj + 32 * wc + 16 * n + 4 * fq;
            uint2 o; o.x = pack2(v[0], v[1]); o.y = pack2(v[2], v[3]);
            *(uint2*)(U + row * 512 + (((col >> 3) ^ (row & 15)) << 4) + (col & 4) * 2) = o;
          }
      }
    __syncthreads();
    if (tid < 128) {
      const int er = tid >> 5, k = tid & 31;
      const int r = (er < 2) ? er : 252 + er;
      const uint4 v = *(const uint4*)(U + r * 512 + ((k ^ (r & 15)) << 4));
      const int ch = (k < 16) ? (tn * 128 + k * 8) : (DFF + tn * 128 + (k - 16) * 8);
      *(uint4*)(edge + ((size_t)u.pm * 4 + er) * UP + ch) = v;
    }
    {
      const int kq = tid & 15, rg = tid >> 4;
      const int cg_ = tn * 128 + kq * 8;
      float g0[8], g1[8], g2[8], gb[8], v0[8], v1[8], v2[8], vb[8];
#define LD8F(dst, ptr) { const float4 t0_ = *(const float4*)(ptr), t1_ = *(const float4*)((ptr) + 4); dst[0] = t0_.x; dst[1] = t0_.y; dst[2] = t0_.z; dst[3] = t0_.w; dst[4] = t1_.x; dst[5] = t1_.y; dst[6] = t1_.z; dst[7] = t1_.w; }
      LD8F(g0, cw + cg_) LD8F(g1, cw + UP + cg_) LD8F(g2, cw + 2 * UP + cg_) LD8F(gb, cb + cg_)
      LD8F(v0, cw + DFF + cg_) LD8F(v1, cw + UP + DFF + cg_) LD8F(v2, cw + 2 * UP + DFF + cg_) LD8F(vb, cb + DFF + cg_)
#undef LD8F
#pragma unroll 2
      for (int i = 0; i < 8; ++i) {
        const int r = 1 + rg + 32 * i;
        const int sq = s0 + r;
        if (r <= 254 && sq < TG) {
          const int sp = sq & (S - 1);
          const float mp = (sp == 0) ? 0.f : 1.f, mn = (sp == S - 1) ? 0.f : 1.f;
          float a0[8], a1[8], a2[8], b0[8], b1[8], b2[8];
          unpack8(*(const uint4*)(U + (r - 1) * 512 + ((kq ^ ((r - 1) & 15)) << 4)), a0);
          unpack8(*(const uint4*)(U + r * 512 + ((kq ^ (r & 15)) << 4)), a1);
          unpack8(*(const uint4*)(U + (r + 1) * 512 + ((kq ^ ((r + 1) & 15)) << 4)), a2);
          unpack8(*(const uint4*)(U + (r - 1) * 512 + (((16 + kq) ^ ((r - 1) & 15)) << 4)), b0);
          unpack8(*(const uint4*)(U + r * 512 + (((16 + kq) ^ (r & 15)) << 4)), b1);
          unpack8(*(const uint4*)(U + (r + 1) * 512 + (((16 + kq) ^ ((r + 1) & 15)) << 4)), b2);
          float o[8];
#pragma unroll
          for (int q = 0; q < 8; ++q) {
            const float gx = a0[q] * mp * g0[q] + a1[q] * g1[q] + a2[q] * mn * g2[q] + gb[q];
            const float vx = b0[q] * mp * v0[q] + b1[q] * v1[q] + b2[q] * mn * v2[q] + vb[q];
            o[q] = gelu_tanh(gx) * vx;
          }
          *(uint4*)(act + (size_t)sq * DFF + cg_) = make_uint4(pack2(o[0], o[1]), pack2(o[2], o[3]), pack2(o[4], o[5]), pack2(o[6], o[7]));
        }
      }
    }
  }
};
__device__ __forceinline__ void ph_ffn_edges(int g_wv, const bf16_t* __restrict__ edge, const float* __restrict__ cw, const float* __restrict__ cb, bf16_t* __restrict__ act, int S) {
  const int total = (TG / 256) * 2 * (DFF / 8);
  for (int e = blockIdx.x * NT + tid_opaque(); e < total; e += gridDim.x * NT) {
    const int ck = e % (DFF / 8), rr = e / (DFF / 8);
    const int pm = rr >> 1, which = rr & 1;
    const int c = ck * 8;
    const int t = pm * 256 + (which ? 255 : 0);
    const int sp = t & (S - 1);
    const float mp = (sp == 0) ? 0.f : 1.f, mn = (sp == S - 1) ? 0.f : 1.f;
    const int pmA = which ? pm : ((pm > 0) ? pm - 1 : pm), slA = which ? 2 : 3;
    const int pmC = which ? ((pm < TG / 256 - 1) ? pm + 1 : pm) : pm, slC = which ? 0 : 1;
    const int slB = which ? 3 : 0;
    float a0[8], a1[8], a2[8], b0[8], b1[8], b2[8];
    unpack8(*(const uint4*)(edge + ((size_t)pmA * 4 + slA) * UP + c), a0);
    unpack8(*(const uint4*)(edge + ((size_t)pm * 4 + slB) * UP + c), a1);
    unpack8(*(const uint4*)(edge + ((size_t)pmC * 4 + slC) * UP + c), a2);
    unpack8(*(const uint4*)(edge + ((size_t)pmA * 4 + slA) * UP + DFF + c), b0);
    unpack8(*(const uint4*)(edge + ((size_t)pm * 4 + slB) * UP + DFF + c), b1);
    unpack8(*(const uint4*)(edge + ((size_t)pmC * 4 + slC) * UP + DFF + c), b2);
    float o[8];
#pragma unroll
    for (int q = 0; q < 8; ++q) {
      const float gx = a0[q] * mp * cw[c + q] + a1[q] * cw[UP + c + q] + a2[q] * mn * cw[2 * UP + c + q] + cb[c + q];
      const float vx = b0[q] * mp * cw[DFF + c + q] + b1[q] * cw[UP + DFF + c + q] + b2[q] * mn * cw[2 * UP + DFF + c + q] + cb[DFF + c + q];
      o[q] = gelu_tanh(gx) * vx;
    }
    *(uint4*)(act + (size_t)t * DFF + c) = make_uint4(pack2(o[0], o[1]), pack2(o[2], o[3]), pack2(o[4], o[5]), pack2(o[6], o[7]));
  }
}

__device__ __forceinline__ void ph_ffn_up(int g_wv, const bf16_t* __restrict__ hb, const bf16_t* __restrict__ W, const float* __restrict__ cw, const float* __restrict__ cb,
                          bf16_t* __restrict__ act, int B, int S, const float* ps, const float* __restrict__ p, bf16_t* __restrict__ pb, bf16_t* edge, char* smem) {
  for (int e = blockIdx.x * NT + tid_opaque(); e < TG * PLE / 8; e += gridDim.x * NT) {
    float4 a = *(const float4*)(p + (size_t)e * 8), b = *(const float4*)(p + (size_t)e * 8 + 4);
    *(uint4*)(pb + (size_t)e * 8) = make_uint4(pack2(a.x, a.y), pack2(a.z, a.w), pack2(b.x, b.y), pack2(b.z, b.w));
  }
  const int nts = TG / 256;
  TileSched TS{nts, UP / 256, 4, DM, 256, 0, 0};
  const int ntiles = nts * (UP / 256);
  for (int t0 = blockIdx.x; t0 < ntiles; t0 += gridDim.x) {
    OneUnit O; TS.fill(t0, O.u);
    __syncthreads();
    gemm_phase(g_wv, (PG8_LAS unsigned char*)smem, Gemm{hb, W, DM, DM}, O, EpiFFN{cw, cb, act, S, ps, edge});
  }
}

struct EpiPle {
  static constexpr bool AFTER_DRAIN = false;
  const float* bg; const bf16_t* prj; float* x; const float* psin;
  const float* gn; bf16_t* xg; float* ps;
  __device__ __forceinline__ void operator()(const f32x4 (&acc)[2][2][4][2], const Unit& u, int wr, int wc, int fr, int fq) const {
    EPI_FENCE;
    asm volatile("" : "+v"(fr), "+v"(fq));
    const float* bp2 = bg + u.pn * 256 + 32 * wc + 4 * fq;
    const float* gp = gn + u.pn * 256 + 32 * wc + 4 * fq;
    const size_t te = (size_t)u.pm * 256 * DM + u.pn * 256;
    char* bx = (char*)(x + te); const char* bp = (const char*)(prj + te); char* bg2 = (char*)(xg + te);
    const unsigned lx = EPI_LANE(DM, 4), lp = EPI_LANE(DM, 2);
    EPI_ROWS {
      float4 xs4[2][2], b4[2][2]; uint2 pq4[2][2];
      const float4* rp4 = (const float4*)(psin + ((size_t)u.pm * 256 + EPI_ROW) * 16);
      const float4 ra = rp4[0], rb = rp4[1], rc = rp4[2], rd = rp4[3];
      EPI_COLS {
        b4[bj][n] = *(const float4*)(bp2 + 128 * bj + 16 * n);
        pq4[bj][n] = *(const uint2*)(bp + (lp + EPI_CONST(DM, 2)));
        xs4[bj][n] = *(const float4*)(bx + (lx + EPI_CONST(DM, 4)));
      }
      EPI_FENCE;
      const float rs = rsqrtf((((ra.x + ra.y) + (ra.z + ra.w)) + ((rb.x + rb.y) + (rb.z + rb.w)) + ((rc.x + rc.y) + (rc.z + rc.w)) + ((rd.x + rd.y) + (rd.z + rd.w))) * (1.0f / DM) + 1e-6f);
      float ssq = 0.f;
      EPI_COLS {
        const f32x4 v = acc[ai][bj][m][n] * rs;
        const float4 b = b4[bj][n]; const uint2 pq = pq4[bj][n]; float4 xs = xs4[bj][n];
        xs.x += sigmoidf_(v[0] + b.x) * lo2f(pq.x); xs.y += sigmoidf_(v[1] + b.y) * hi2f(pq.x);
        xs.z += sigmoidf_(v[2] + b.z) * lo2f(pq.y); xs.w += sigmoidf_(v[3] + b.w) * hi2f(pq.y);
        *(float4*)(bx + (lx + EPI_CONST(DM, 4))) = xs;
        if (xg) {
          const float4 g4 = *(const float4*)(gp + 128 * bj + 16 * n);
          uint2 q; q.x = pack2(xs.x * g4.x, xs.y * g4.y); q.y = pack2(xs.z * g4.z, xs.w * g4.w);
          *(uint2*)(bg2 + (lp + EPI_CONST(DM, 2))) = q;
          ssq += (xs.x * xs.x + xs.y * xs.y) + (xs.z * xs.z + xs.w * xs.w);
        }
      }
      if (xg) {
        ssq += __shfl_xor(ssq, 16, 64);
        ssq += __shfl_xor(ssq, 32, 64);
        if (fq == 0) ps[((size_t)u.pm * 256 + EPI_ROW) * 16 + u.pn * 4 + wc] = ssq;
      }
      EPI_FENCE;
    }
  }
};
__device__ __forceinline__ void ph_ple(int g_wv, const bf16_t* __restrict__ hb, const bf16_t* __restrict__ Wg, const float* __restrict__ bg, const bf16_t* __restrict__ pb,
                       const bf16_t* __restrict__ Wp, bf16_t* prj, float* x, const float* psin, const float* gn, bf16_t* xg, float* ps, char* smem) {
  TileSched S1{TG / 256, DM / 256, 4, PLE, 256, 0, 0};
  gemm_phase(g_wv, (PG8_LAS unsigned char*)smem, Gemm{pb, Wp, PLE, PLE}, S1, EpiBf16<false>{nullptr, prj, nullptr});
  __syncthreads();
  TileSched S2{TG / 256, DM / 256, 4, DM, 256, 0, 0};
  gemm_phase(g_wv, (PG8_LAS unsigned char*)smem, Gemm{hb, Wg, DM, DM}, S2, EpiPle{bg, prj, x, psin, gn, xg, ps});
}

__device__ __forceinline__ void ph_attention(int g_wv, const bf16_t* __restrict__ z2, const float2* __restrict__ rot, float* __restrict__ opart, float* __restrict__ lsep,
                             int B, int S, char* smem) {
  const int tidf = tid_opaque(), half = tidf >> 8;
  const int tid = tidf & 255, lane = tid & 63, w4 = tid >> 6, quad = lane >> 4, l15 = lane & 15;
  bf16_t* sK = (bf16_t*)(smem + half * 53248);
  bf16_t* sVt = (bf16_t*)(smem + half * 53248 + 192 * 72 * 2);
  const int tps = S / 64;
  const int per_g = B * 4 * tps;
  const int nunits = 3 * per_g;
  for (int u = blockIdx.x * 2 + half; u < nunits; u += gridDim.x * 2) {
    const int ltps = 31 - __clz(tps), lpg = 31 - __clz(per_g);
    int g = u >> lpg, rem = u & (per_g - 1);
    int b = rem >> (ltps + 2), rem2 = rem & (4 * tps - 1);
    int hg = rem2 >> ltps, w = rem2 & (tps - 1);
    int dil = (g == 0) ? 1 : (g == 1 ? 4 : 16);
    const int ldil = (g == 0) ? 0 : (g == 1 ? 2 : 4);
    int Ls = S >> ldil;
    int lt = w >> ldil, rho = w & (dil - 1);
    int l0 = lt * 64;
    int head = g * 4 + hg;
    const bf16_t* zb = z2 + (size_t)b * S * ATT_IN;
    __syncthreads();
#pragma unroll
    for (int it = 0; it < 3; ++it) {
      int e = tid + 256 * it;
      int jj = e >> 2, part = e & 3;
      int lk = l0 - 64 + jj;
      bool valid = (lk >= 0) && (lk < Ls);
      int s = lk * dil + rho;
      uint4 k0 = make_uint4(0, 0, 0, 0), k1 = k0, v0 = k0, v1 = k0;
      if (valid) {
        const bf16_t* kr = zb + (size_t)s * ATT_IN + 768 + head * 64 + part * 16;
        const bf16_t* vr = zb + (size_t)s * ATT_IN + 1536 + head * 64 + part * 16;
        k0 = *(const uint4*)kr; k1 = *(const uint4*)(kr + 8);
        v0 = *(const uint4*)vr; v1 = *(const uint4*)(vr + 8);
        if (part == 0) {
          const float2* rt = rot + (size_t)s * 8;
          unsigned x1[4] = {k0.x, k0.y, k0.z, k0.w}, x2[4] = {k1.x, k1.y, k1.z, k1.w};
#pragma unroll
          for (int q = 0; q < 4; ++q) {
            float2 c0 = rt[2 * q], c1 = rt[2 * q + 1];
            float a0 = lo2f(x1[q]), a1 = hi2f(x1[q]), b0 = lo2f(x2[q]), b1 = hi2f(x2[q]);
            x1[q] = pack2(a0 * c0.x - b0 * c0.y, a1 * c1.x - b1 * c1.y);
            x2[q] = pack2(b0 * c0.x + a0 * c0.y, b1 * c1.x + a1 * c1.y);
          }
          k0 = make_uint4(x1[0], x1[1], x1[2], x1[3]); k1 = make_uint4(x2[0], x2[1], x2[2], x2[3]);
        }
      }
      *(uint4*)(sK + jj * 72 + part * 16) = k0;
      *(uint4*)(sK + jj * 72 + part * 16 + 8) = k1;
      unsigned vv[8] = {v0.x, v0.y, v0.z, v0.w, v1.x, v1.y, v1.z, v1.w};
#pragma unroll
      for (int q = 0; q < 8; ++q) {
        sVt[(part * 16 + 2 * q) * 200 + jj] = (bf16_t)(vv[q] & 0xffffu);
        sVt[(part * 16 + 2 * q + 1) * 200 + jj] = (bf16_t)(vv[q] >> 16);
      }
    }
    const int qi = w4 * 16 + l15;
    const int sq = (l0 + qi) * dil + rho;
    bf16x8 qf[2];
    {
      const bf16_t* qr = zb + (size_t)sq * ATT_IN + head * 64;
      uint4 c[2];
      c[0] = *(const uint4*)(qr + quad * 8);
      c[1] = *(const uint4*)(qr + 32 + quad * 8);
      unsigned xs[4] = {c[0].x, c[0].y, c[0].z, c[0].w};
      if (quad < 2) {
        uint4 oth = *(const uint4*)(qr + (quad ^ 1) * 8);
        unsigned xo[4] = {oth.x, oth.y, oth.z, oth.w};
        const float2* rt = rot + (size_t)sq * 8;
#pragma unroll
        for (int q = 0; q < 4; ++q) {
          float2 c0 = rt[2 * q], c1 = rt[2 * q + 1];
          float a0 = lo2f(xs[q]), a1 = hi2f(xs[q]), b0 = lo2f(xo[q]), b1 = hi2f(xo[q]);
          float r0 = (quad == 0) ? (a0 * c0.x - b0 * c0.y) : (a0 * c0.x + b0 * c0.y);
          float r1 = (quad == 0) ? (a1 * c1.x - b1 * c1.y) : (a1 * c1.x + b1 * c1.y);
          xs[q] = pack2(r0, r1);
        }
      }
      unsigned all[8] = {xs[0], xs[1], xs[2], xs[3], c[1].x, c[1].y, c[1].z, c[1].w};
#pragma unroll
      for (int q = 0; q < 8; ++q) all[q] = pack2(lo2f(all[q]) * 0.125f, hi2f(all[q]) * 0.125f);
      uint4 t0 = make_uint4(all[0], all[1], all[2], all[3]), t1 = make_uint4(all[4], all[5], all[6], all[7]);
      qf[0] = *(bf16x8*)&t0; qf[1] = *(bf16x8*)&t1;
    }
    __syncthreads();
    const int kt0 = (w4 < 2) ? w4 : 2;
    f32x4 sc[10];
#pragma unroll
    for (int kt = 0; kt < 10; ++kt) {
      f32x4 a = (f32x4){0.f, 0.f, 0.f, 0.f};
#pragma unroll
      for (int ks = 0; ks < 2; ++ks) {
        bf16x8 kf = *(const bf16x8*)(sK + ((kt0 + kt) * 16 + l15) * 72 + ks * 32 + quad * 8);
        a = __builtin_amdgcn_mfma_f32_16x16x32_bf16(kf, qf[ks], a, 0, 0, 0);
      }
      sc[kt] = a;
    }
    float mx = -1e30f;
#pragma unroll
    for (int kt = 0; kt < 10; ++kt)
#pragma unroll
      for (int r = 0; r < 4; ++r) {
        int jj = (kt0 + kt) * 16 + quad * 4 + r;
        int lk = l0 - 64 + jj;
        bool valid = (jj >= qi) && (jj <= qi + 128) && (lk >= 0) && (lk < Ls);
        float sv = valid ? sc[kt][r] : -1e30f;
        sc[kt][r] = sv;
        mx = fmaxf(mx, sv);
      }
    mx = fmaxf(mx, __shfl_xor(mx, 16, 64));
    mx = fmaxf(mx, __shfl_xor(mx, 32, 64));
    float den = 0.f;
#pragma unroll
    for (int kt = 0; kt < 10; ++kt)
#pragma unroll
      for (int r = 0; r < 4; ++r) { float p = __expf(sc[kt][r] - mx); sc[kt][r] = p; den += p; }
    den += __shfl_xor(den, 16, 64);
    den += __shfl_xor(den, 32, 64);
    f32x4 oacc[4];
#pragma unroll
    for (int dt = 0; dt < 4; ++dt) oacc[dt] = (f32x4){0.f, 0.f, 0.f, 0.f};
#pragma unroll
    for (int pp = 0; pp < 5; ++pp) {
      uint4 pk = make_uint4(pack2(sc[2 * pp][0], sc[2 * pp][1]), pack2(sc[2 * pp][2], sc[2 * pp][3]),
                            pack2(sc[2 * pp + 1][0], sc[2 * pp + 1][1]), pack2(sc[2 * pp + 1][2], sc[2 * pp + 1][3]));
      bf16x8 pf = *(bf16x8*)&pk;
#pragma unroll
      for (int dt = 0; dt < 4; ++dt) {
        const bf16_t* vp = sVt + (dt * 16 + l15) * 200 + (kt0 + 2 * pp) * 16 + quad * 4;
        uint2 va = *(const uint2*)vp, vb = *(const uint2*)(vp + 16);
        uint4 vk = make_uint4(va.x, va.y, vb.x, vb.y);
        bf16x8 vf = *(bf16x8*)&vk;
        oacc[dt] = __builtin_amdgcn_mfma_f32_16x16x32_bf16(vf, pf, oacc[dt], 0, 0, 0);
      }
    }
    float inv = 1.0f / den;
    float* op = opart + ((size_t)g * TG + (size_t)b * S + sq) * 256 + hg * 64;
#pragma unroll
    for (int dt = 0; dt < 4; ++dt)
      *(float4*)(op + dt * 16 + quad * 4) = make_float4(oacc[dt][0] * inv, oacc[dt][1] * inv, oacc[dt][2] * inv, oacc[dt][3] * inv);
    if (quad == 0) lsep[((size_t)g * TG + (size_t)b * S + sq) * 4 + hg] = mx + __logf(den);
  }
}

__device__ __forceinline__ void ph_attn_combine(int g_wv, const float* __restrict__ opart, const float* __restrict__ lsep, bf16_t* __restrict__ yab) {
  const int total = TG * 64;
  for (int e = blockIdx.x * NT + tid_opaque(); e < total; e += gridDim.x * NT) {
    int t = e >> 6, c = (e & 63) * 4, hg = c >> 6;
    float l0 = lsep[(size_t)t * 4 + hg], l1 = lsep[((size_t)TG + t) * 4 + hg], l2 = lsep[((size_t)2 * TG + t) * 4 + hg];
    float m = fmaxf(l0, fmaxf(l1, l2));
    float w0 = __expf(l0 - m), w1 = __expf(l1 - m), w2 = __expf(l2 - m);
    float inv = 1.0f / (w0 + w1 + w2);
    w0 *= inv; w1 *= inv; w2 *= inv;
    float4 a = *(const float4*)(opart + (size_t)t * 256 + c);
    float4 b = *(const float4*)(opart + ((size_t)TG + t) * 256 + c);
    float4 d = *(const float4*)(opart + ((size_t)2 * TG + t) * 256 + c);
    uint2 o;
    o.x = pack2(w0 * a.x + w1 * b.x + w2 * d.x, w0 * a.y + w1 * b.y + w2 * d.y);
    o.y = pack2(w0 * a.z + w1 * b.z + w2 * d.z, w0 * a.w + w1 * b.w + w2 * d.w);
    *(uint2*)(yab + (size_t)t * AB_OUT + 512 + c) = o;
  }
}

__device__ __forceinline__ void ph_rwkv_prep(int g_wv, const bf16_t* __restrict__ z1, const float* __restrict__ mu, bf16_t* __restrict__ rkv, bf16_t* __restrict__ L, int S,
                                             const float* __restrict__ k_k, float* __restrict__ knorm) {
  const int total = TG * 240;
  for (int e = blockIdx.x * NT + tid_opaque(); e < total; e += gridDim.x * NT) {
    const int t = e / 240, c = (e - t * 240) * 8;
    const int s = t & (S - 1);
    const bf16_t* zc = z1 + (size_t)t * RWKV_IN + c;
    const uint4 uc = *(const uint4*)zc;
    uint4 um = make_uint4(0, 0, 0, 0), up = make_uint4(0, 0, 0, 0);
    if (s > 0) um = *(const uint4*)(zc - RWKV_IN);
    if (s < S - 1) up = *(const uint4*)(zc + RWKV_IN);
    const float4 m0 = *(const float4*)(mu + c), m1 = *(const float4*)(mu + c + 4);
    const unsigned ucs[4] = {uc.x, uc.y, uc.z, uc.w}, ums[4] = {um.x, um.y, um.z, um.w}, ups[4] = {up.x, up.y, up.z, up.w};
    const float mus[8] = {m0.x, m0.y, m0.z, m0.w, m1.x, m1.y, m1.z, m1.w};
    unsigned o[4];
#pragma unroll
    for (int q = 0; q < 4; ++q) {
      float z0 = lo2f(ucs[q]), z1v = hi2f(ucs[q]);
      float r0 = z0 + mus[2 * q] * (0.5f * (lo2f(ums[q]) + lo2f(ups[q])) - z0);
      float r1 = z1v + mus[2 * q + 1] * (0.5f * (hi2f(ums[q]) + hi2f(ups[q])) - z1v);
      if (c >= 1536 && c < 1664) { r0 = tanhf_(r0); r1 = tanhf_(r1); }
      else if (c >= 1792) { r0 = sigmoidf_(r0); r1 = sigmoidf_(r1); }
      o[q] = pack2(r0, r1);
    }
    if (c < 1536) *(uint4*)(rkv + (size_t)t * 1536 + c) = make_uint4(o[0], o[1], o[2], o[3]);
    else *(uint4*)(L + (size_t)t * KLORA + c - 1536) = make_uint4(o[0], o[1], o[2], o[3]);
    const bool isk = (c >= 512 && c < 1024);
    float ss = 0.f;
    if (isk) {
      const float4 q0 = *(const float4*)(k_k + c - 512), q1 = *(const float4*)(k_k + c - 512 + 4);
      const float kq[8] = {q0.x, q0.y, q0.z, q0.w, q1.x, q1.y, q1.z, q1.w};
#pragma unroll
      for (int q = 0; q < 4; ++q) { float p0 = lo2f(o[q]) * kq[2 * q], p1 = hi2f(o[q]) * kq[2 * q + 1]; ss += p0 * p0 + p1 * p1; }
    }
    ss += __shfl_xor(ss, 1, 64); ss += __shfl_xor(ss, 2, 64); ss += __shfl_xor(ss, 4, 64);
    if (isk && ((c & 63) == 0)) knorm[(size_t)t * 8 + ((c - 512) >> 6)] = rsqrtf(ss + 1e-12f);
  }
}

struct ScanRaw { unsigned short r[TB], k[TB], v[TB], e[TB], a[TB]; float kn[TB]; };
__device__ __forceinline__ void scan_load(ScanRaw& raw, const bf16_t* __restrict__ rkv, const bf16_t* __restrict__ ea, const float* __restrict__ knorm,
                                          int b, int S, int h, int d, int tau0, int lane) {
  unsigned zl = 0; asm volatile("" : "+v"(zl));
#pragma unroll
  for (int i = 0; i < TB; ++i) {
    int tau = tau0 + i;
    int tt = (d == 0) ? tau : (S - 1 - tau);
    size_t row = (size_t)b * S + tt;
    raw.r[i] = rkv[row * 1536 + h * 64 + lane];
    raw.k[i] = rkv[row * 1536 + 512 + h * 64 + lane];
    raw.v[i] = rkv[row * 1536 + 1024 + h * 64 + lane];
    raw.e[i] = ea[row * 2048 + d * 512 + h * 64 + lane];
    raw.a[i] = ea[row * 2048 + 1024 + d * 512 + h * 64 + lane];
    raw.kn[i] = knorm[row * 8 + h + zl];
  }
}
__device__ __forceinline__ void scan_stage(float* st, const ScanRaw& raw, float kkp, float kap, int lane) {
#pragma unroll
  for (int i = 0; i < TB; ++i) {
    float rv = bf2f(raw.r[i]), kv = bf2f(raw.k[i]), vv = bf2f(raw.v[i]), e = bf2f(raw.e[i]), a = bf2f(raw.a[i]);
    float kk = kv * kkp * raw.kn[i];
    float* s = st + i * 384;
    s[lane] = kk;
    s[64 + lane] = __expf(-e);
    s[128 + lane] = kk * a;
    s[192 + lane] = kv * (1.0f + (a - 1.0f) * kap);
    s[256 + lane] = rv;
    s[320 + lane] = vv;
  }
}

#define SB_ __builtin_amdgcn_sched_barrier(0)
typedef float v2f __attribute__((ext_vector_type(2)));
__device__ __forceinline__ v2f lo2(const float4& a) { return (v2f){a.x, a.y}; }
__device__ __forceinline__ v2f hi2(const float4& a) { return (v2f){a.z, a.w}; }
template <bool EMIT_Y>
__device__ __forceinline__ void scan_block(v2f (&S2)[32], const float* st, float vsel, int lane, bf16_t* __restrict__ yout, long ystride) {
  float4 bA[8], bB[8];
#pragma unroll
  for (int z = 0; z < 8; ++z) bA[z] = *(const float4*)(st + 4 * z);
  for (int i = 0; i < TB; ++i) {
    const float* s = st + i * 384;
    const float vv = s[320 + lane] * vsel;
#pragma unroll
    for (int z = 0; z < 8; ++z) bB[z] = *(const float4*)(s + 32 + 4 * z);
    SB_;
    v2f accA = (v2f){0.f, 0.f}, accB = (v2f){0.f, 0.f};
#pragma unroll
    for (int z = 0; z < 8; ++z) { accA += S2[2 * z] * lo2(bA[z]); accB += S2[2 * z + 1] * hi2(bA[z]); }
    SB_;
#pragma unroll
    for (int z = 0; z < 2; ++z) { bA[z] = *(const float4*)(s + 64 + 4 * z); bA[2 + z] = *(const float4*)(s + 128 + 4 * z); bA[4 + z] = *(const float4*)(s + 192 + 4 * z); if (EMIT_Y) bA[6 + z] = *(const float4*)(s + 256 + 4 * z); }
    SB_;
#pragma unroll
    for (int z = 0; z < 8; ++z) { accA += S2[16 + 2 * z] * lo2(bB[z]); accB += S2[16 + 2 * z + 1] * hi2(bB[z]); }
    accA += accB;
    const float sa = accA.x + accA.y;
    const v2f nsa2 = (v2f){-sa, -sa}, vv2 = (v2f){vv, vv};
    v2f yA = (v2f){0.f, 0.f}, yB = (v2f){0.f, 0.f};
    SB_;
#pragma unroll
    for (int g = 0; g < 8; ++g) {
      float4(&cur)[8] = (g & 1) ? bB : bA;
      float4(&nxt)[8] = (g & 1) ? bA : bB;
      if (g < 7) {
#pragma unroll
        for (int z = 0; z < 2; ++z) {
          nxt[z] = *(const float4*)(s + 64 + 8 * (g + 1) + 4 * z); nxt[2 + z] = *(const float4*)(s + 128 + 8 * (g + 1) + 4 * z);
          nxt[4 + z] = *(const float4*)(s + 192 + 8 * (g + 1) + 4 * z); if (EMIT_Y) nxt[6 + z] = *(const float4*)(s + 256 + 8 * (g + 1) + 4 * z);
        }
      } else {
#pragma unroll
        for (int z = 0; z < 8; ++z) nxt[z] = *(const float4*)(s + 384 + 4 * z);
      }
      SB_;
#pragma unroll
      for (int z = 0; z < 2; ++z) {
        const int j = 4 * g + 2 * z;
        const float4 w4 = cur[z], a4 = cur[2 + z], d4 = cur[4 + z];
        S2[j] = S2[j] * lo2(w4) + nsa2 * lo2(a4) + vv2 * lo2(d4);
        S2[j + 1] = S2[j + 1] * hi2(w4) + nsa2 * hi2(a4) + vv2 * hi2(d4);
        if (EMIT_Y) { const float4 r4 = cur[6 + z]; yA += S2[j] * lo2(r4); yB += S2[j + 1] * hi2(r4); }
      }
      SB_;
    }
    if (EMIT_Y) { yA += yB; yout[(long)i * ystride] = f2bf(yA.x + yA.y); }
  }
}

__device__ __forceinline__ void scan_block_qm(v2f (&SQ)[32], v2f (&SM)[32], const float* st, int lane) {
  float4 bX[6], bY[6];
#pragma unroll
  for (int z = 0; z < 4; ++z) bX[z] = *(const float4*)(st + 4 * z);
  for (int i = 0; i < TB; ++i) {
    const float* s = st + i * 384;
    const float vv = s[320 + lane];
    v2f aQ0 = (v2f){0.f, 0.f}, aQ1 = (v2f){0.f, 0.f}, aM0 = (v2f){0.f, 0.f}, aM1 = (v2f){0.f, 0.f};
#pragma unroll
    for (int g = 0; g < 4; ++g) {
      float4(&cur)[6] = (g & 1) ? bY : bX;
      float4(&nxt)[6] = (g & 1) ? bX : bY;
      if (g < 3) {
#pragma unroll
        for (int z = 0; z < 4; ++z) nxt[z] = *(const float4*)(s + 16 * (g + 1) + 4 * z);
      } else {
#pragma unroll
        for (int z = 0; z < 2; ++z) { nxt[z] = *(const float4*)(s + 64 + 4 * z); nxt[2 + z] = *(const float4*)(s + 128 + 4 * z); nxt[4 + z] = *(const float4*)(s + 192 + 4 * z); }
      }
      SB_;
#pragma unroll
      for (int z = 0; z < 4; ++z) {
        const int j = 8 * g + 2 * z;
        aQ0 += SQ[j] * lo2(cur[z]); aQ1 += SQ[j + 1] * hi2(cur[z]);
        aM0 += SM[j] * lo2(cur[z]); aM1 += SM[j + 1] * hi2(cur[z]);
      }
      SB_;
    }
    aQ0 += aQ1; aM0 += aM1;
    const float saq = aQ0.x + aQ0.y, sam = aM0.x + aM0.y;
    const v2f nq2 = (v2f){-saq, -saq}, nm2 = (v2f){-sam, -sam}, vv2 = (v2f){vv, vv};
#pragma unroll
    for (int g = 0; g < 8; ++g) {
      float4(&cur)[6] = (g & 1) ? bY : bX;
      float4(&nxt)[6] = (g & 1) ? bX : bY;
      if (g < 7) {
#pragma unroll
        for (int z = 0; z < 2; ++z) { nxt[z] = *(const float4*)(s + 64 + 8 * (g + 1) + 4 * z); nxt[2 + z] = *(const float4*)(s + 128 + 8 * (g + 1) + 4 * z); nxt[4 + z] = *(const float4*)(s + 192 + 8 * (g + 1) + 4 * z); }
      } else {
#pragma unroll
        for (int z = 0; z < 4; ++z) nxt[z] = *(const float4*)(s + 384 + 4 * z);
      }
      SB_;
#pragma unroll
      for (int z = 0; z < 2; ++z) {
        const int j = 4 * g + 2 * z;
        const float4 w4 = cur[z], a4 = cur[2 + z], d4 = cur[4 + z];
        SQ[j] = SQ[j] * lo2(w4) + nq2 * lo2(a4) + vv2 * lo2(d4);
        SQ[j + 1] = SQ[j + 1] * hi2(w4) + nq2 * hi2(a4) + vv2 * hi2(d4);
        SM[j] = SM[j] * lo2(w4) + nm2 * lo2(a4);
        SM[j + 1] = SM[j + 1] * hi2(w4) + nm2 * hi2(a4);
      }
      SB_;
    }
  }
}

__device__ __forceinline__ void ph_scan_pass1(int g_wv, const bf16_t* __restrict__ rkv, const bf16_t* __restrict__ ea, const float* __restrict__ knorm, const float* __restrict__ k_k, const float* __restrict__ k_a,
                              float* __restrict__ Qb, float* __restrict__ Mb, int B, int S, char* smem) {
  const int NC = S / CHUNK_L;
  if (NC <= 1) return;
  const int lane = tid_opaque() & 63, wv = __builtin_amdgcn_readfirstlane(tid_opaque() >> 6);
  float* st = (float*)smem + wv * ((TB + 1) * 384);
  const int nunits = B * 8 * 2 * (NC - 1);
  for (int u = wv * gridDim.x + blockIdx.x; u < nunits; u += NW * gridDim.x) {
    const int nbhd = B * 16;
    int bhd = u & (nbhd - 1), ci = u >> (31 - __clz(nbhd));
    int d = bhd & 1, h = (bhd >> 1) & 7, b = bhd >> 4;
    float kkp = k_k[h * 64 + lane], kap = k_a[h * 64 + lane];
    v2f SQ[32], SM[32];
    int lane_i = lane;
    asm volatile("" : "+v"(lane_i));
#pragma unroll
    for (int k = 0; k < 32; ++k) { SQ[k] = (v2f){0.f, 0.f}; SM[k] = (v2f){(2 * k == lane_i) ? 1.f : 0.f, (2 * k + 1 == lane_i) ? 1.f : 0.f}; }
    ScanRaw raw;
    scan_load(raw, rkv, ea, knorm, b, S, h, d, ci * CHUNK_L, lane);
    for (int tb = 0; tb < CHUNK_L / TB; ++tb) {
      scan_stage(st, raw, kkp, kap, lane);
      if (tb + 1 < CHUNK_L / TB) scan_load(raw, rkv, ea, knorm, b, S, h, d, ci * CHUNK_L + (tb + 1) * TB, lane);
      scan_block_qm(SQ, SM, st, lane);
    }
    float* qo = Qb + ((size_t)bhd * NC + ci) * 4096 + lane * 64;
    float* mo = Mb + ((size_t)bhd * NC + ci) * 4096 + lane * 64;
#pragma unroll
    for (int q = 0; q < 16; ++q) {
      *(float4*)(qo + 4 * q) = make_float4(SQ[2 * q].x, SQ[2 * q].y, SQ[2 * q + 1].x, SQ[2 * q + 1].y);
      *(float4*)(mo + 4 * q) = make_float4(SM[2 * q].x, SM[2 * q].y, SM[2 * q + 1].x, SM[2 * q + 1].y);
    }
  }
}

__device__ __forceinline__ void ph_scan_pass2(int g_wv, const float* __restrict__ Qb, const float* __restrict__ Mb, float* __restrict__ Sib, int B, int S, char* smem) {
  const int NC = S / CHUNK_L;
  if (NC <= 1) return;
  float* sS = (float*)smem;
  float* sM = sS + 64 * 65;
  const int tid = tid_opaque(), v = (tid >> 2) & 63, q = tid & 3;
  const bool act = tid < 256;
  for (int bhd = blockIdx.x; bhd < B * 16; bhd += gridDim.x) {
    float cur[16];
#pragma unroll
    for (int i = 0; i < 16; ++i) cur[i] = 0.f;
    for (int c = 0; c < NC; ++c) {
      if (act) {
        float* so = Sib + ((size_t)bhd * NC + c) * 4096 + v * 64 + q * 16;
#pragma unroll
        for (int i = 0; i < 4; ++i) *(float4*)(so + 4 * i) = make_float4(cur[4 * i], cur[4 * i + 1], cur[4 * i + 2], cur[4 * i + 3]);
      }
      if (c == NC - 1) break;
      __syncthreads();
      if (act) {
#pragma unroll
        for (int i = 0; i < 16; ++i) sS[v * 65 + q * 16 + i] = cur[i];
        const float* mp = Mb + ((size_t)bhd * NC + c) * 4096;
#pragma unroll
        for (int i = 0; i < 4; ++i) *(float4*)(sM + (tid + 256 * i) * 4) = *(const float4*)(mp + (tid + 256 * i) * 4);
      }
      __syncthreads();
      if (act) {
        const float* qp = Qb + ((size_t)bhd * NC + c) * 4096 + v * 64 + q * 16;
        float nw[16];
#pragma unroll
        for (int i = 0; i < 4; ++i) { float4 t4 = *(const float4*)(qp + 4 * i); nw[4 * i] = t4.x; nw[4 * i + 1] = t4.y; nw[4 * i + 2] = t4.z; nw[4 * i + 3] = t4.w; }
#pragma unroll 4
        for (int j = 0; j < 64; ++j) {
          float sv = sS[v * 65 + j];
#pragma unroll
          for (int i = 0; i < 4; ++i) {
            float4 m4 = *(const float4*)(sM + j * 64 + q * 16 + 4 * i);
            nw[4 * i] += sv * m4.x; nw[4 * i + 1] += sv * m4.y; nw[4 * i + 2] += sv * m4.z; nw[4 * i + 3] += sv * m4.w;
          }
        }
#pragma unroll
        for (int i = 0; i < 16; ++i) cur[i] = nw[i];
      }
    }
    __syncthreads();
  }
}

__device__ __forceinline__ void ph_scan_pass3(int g_wv, const bf16_t* __restrict__ rkv, const bf16_t* __restrict__ ea, const float* __restrict__ knorm, const float* __restrict__ k_k, const float* __restrict__ k_a,
                              const float* __restrict__ Sib, bf16_t* __restrict__ yp, int B, int S, char* smem) {
  const int NC = S / CHUNK_L;
  const int lane = tid_opaque() & 63, wv = __builtin_amdgcn_readfirstlane(tid_opaque() >> 6);
  float* st = (float*)smem + wv * ((TB + 1) * 384);
  const int nunits = B * 16 * NC;
  for (int u = wv * gridDim.x + blockIdx.x; u < nunits; u += NW * gridDim.x) {
    int ci = u & (NC - 1), bhd = u >> (31 - __clz(NC));
    int d = bhd & 1, h = (bhd >> 1) & 7, b = bhd >> 4;
    float kkp = k_k[h * 64 + lane], kap = k_a[h * 64 + lane];
    v2f S2[32];
    if (NC > 1) {
      const float* si = Sib + ((size_t)bhd * NC + ci) * 4096 + lane * 64;
#pragma unroll
      for (int q = 0; q < 16; ++q) { float4 t4 = *(const float4*)(si + 4 * q); S2[2 * q] = (v2f){t4.x, t4.y}; S2[2 * q + 1] = (v2f){t4.z, t4.w}; }
    } else {
#pragma unroll
      for (int k = 0; k < 32; ++k) S2[k] = (v2f){0.f, 0.f};
    }
    ScanRaw raw;
    scan_load(raw, rkv, ea, knorm, b, S, h, d, ci * CHUNK_L, lane);
    for (int tb = 0; tb < CHUNK_L / TB; ++tb) {
      int tau0 = ci * CHUNK_L + tb * TB;
      scan_stage(st, raw, kkp, kap, lane);
      if (tb + 1 < CHUNK_L / TB) scan_load(raw, rkv, ea, knorm, b, S, h, d, tau0 + TB, lane);
      int tt0 = (d == 0) ? tau0 : (S - 1 - tau0);
      bf16_t* yo = yp + ((size_t)d * TG + (size_t)b * S + tt0) * RW + h * 64 + lane;
      scan_block<true>(S2, st, 1.0f, lane, yo, (d == 0) ? (long)RW : -(long)RW);
    }
  }
}

__device__ __forceinline__ float red8(float v) { v += __shfl_xor(v, 1, 64); v += __shfl_xor(v, 2, 64); v += __shfl_xor(v, 4, 64); return v; }
__device__ __forceinline__ void ph_rwkv_post(int g_wv, const bf16_t* __restrict__ yp, const bf16_t* __restrict__ rkv, const bf16_t* __restrict__ ea, const bf16_t* __restrict__ gb,
                             const float* __restrict__ k_a, const float* __restrict__ r_k, const float* __restrict__ ln_g, const float* __restrict__ ln_b,
                             bf16_t* __restrict__ yab) {
  const int lane = tid_opaque() & 63, wv = __builtin_amdgcn_readfirstlane(tid_opaque() >> 6);
  const int c = (lane >> 3) * 64 + (lane & 7) * 8;
  float ka[8], rk[8], lg[8], lb[8];
  {
    float4 t0 = *(const float4*)(k_a + c), t1 = *(const float4*)(k_a + c + 4); ka[0] = t0.x; ka[1] = t0.y; ka[2] = t0.z; ka[3] = t0.w; ka[4] = t1.x; ka[5] = t1.y; ka[6] = t1.z; ka[7] = t1.w;
    t0 = *(const float4*)(r_k + c); t1 = *(const float4*)(r_k + c + 4); rk[0] = t0.x; rk[1] = t0.y; rk[2] = t0.z; rk[3] = t0.w; rk[4] = t1.x; rk[5] = t1.y; rk[6] = t1.z; rk[7] = t1.w;
    t0 = *(const float4*)(ln_g + c); t1 = *(const float4*)(ln_g + c + 4); lg[0] = t0.x; lg[1] = t0.y; lg[2] = t0.z; lg[3] = t0.w; lg[4] = t1.x; lg[5] = t1.y; lg[6] = t1.z; lg[7] = t1.w;
    t0 = *(const float4*)(ln_b + c); t1 = *(const float4*)(ln_b + c + 4); lb[0] = t0.x; lb[1] = t0.y; lb[2] = t0.z; lb[3] = t0.w; lb[4] = t1.x; lb[5] = t1.y; lb[6] = t1.z; lb[7] = t1.w;
  }
  for (int t = blockIdx.x * NW + wv; t < TG; t += gridDim.x * NW) {
    const uint4 uy0 = *(const uint4*)(yp + (size_t)t * RW + c), uy1 = *(const uint4*)(yp + ((size_t)TG + t) * RW + c);
    const uint4 ur = *(const uint4*)(rkv + (size_t)t * 1536 + c), uk = *(const uint4*)(rkv + (size_t)t * 1536 + 512 + c), uv = *(const uint4*)(rkv + (size_t)t * 1536 + 1024 + c);
    const uint4 ua0 = *(const uint4*)(ea + (size_t)t * 2048 + 1024 + c), ua1 = *(const uint4*)(ea + (size_t)t * 2048 + 1536 + c);
    const uint4 ug = *(const uint4*)(gb + (size_t)t * RW + c);
    float y0[8], y1[8], r[8], k[8], v[8], a0[8], a1[8], g[8];
    unpack8(uy0, y0); unpack8(uy1, y1); unpack8(ur, r); unpack8(uk, k); unpack8(uv, v); unpack8(ua0, a0); unpack8(ua1, a1); unpack8(ug, g);
    float y[8], sy = 0.f, sb = 0.f;
#pragma unroll
    for (int i = 0; i < 8; ++i) {
      y[i] = y0[i] + y1[i]; sy += y[i];
      const float kd = k[i] * (2.0f + (a0[i] + a1[i] - 2.0f) * ka[i]);
      sb += r[i] * kd * rk[i];
    }
    const float mean = red8(sy) * (1.0f / 64.0f);
    const float bon = red8(sb);
    float sv = 0.f;
#pragma unroll
    for (int i = 0; i < 8; ++i) { y[i] -= mean; sv += y[i] * y[i]; }
    const float rstd = rsqrtf(red8(sv) * (1.0f / 64.0f) + 64e-5f);
    float o[8];
#pragma unroll
    for (int i = 0; i < 8; ++i) o[i] = (y[i] * rstd * lg[i] + lb[i] + bon * v[i]) * g[i];
    *(uint4*)(yab + (size_t)t * AB_OUT + c) = make_uint4(pack2(o[0], o[1]), pack2(o[2], o[3]), pack2(o[4], o[5]), pack2(o[6], o[7]));
  }
}

__device__ __forceinline__ void ph_pool(int g_wv, const bf16_t* __restrict__ u, bf16_t* __restrict__ dd, int S) {
  const int total = (TG / 4) * 128;
  for (int e = blockIdx.x * NT + tid_opaque(); e < total; e += gridDim.x * NT) {
    const int t0 = (e >> 7) * 4, c = (e & 127) * 8;
    const int s0 = t0 & (S - 1);
    const int g = c >> 8, rad = 1 << g;
    const int lo = (s0 - rad < 0) ? 0 : s0 - rad;
    const int hi = (s0 + 3 + rad + 1 > S) ? S : s0 + 3 + rad + 1;
    float acc[4][8];
    float ctr[4][8];
#pragma unroll
    for (int j = 0; j < 4; ++j)
#pragma unroll
      for (int i = 0; i < 8; ++i) { acc[j][i] = 0.f; ctr[j][i] = 0.f; }
    const bf16_t* base = u + (size_t)(t0 - s0) * DM + c;
    for (int sp = lo; sp < hi; ++sp) {
      float f[8];
      unpack8(*(const uint4*)(base + (size_t)sp * DM), f);
#pragma unroll
      for (int j = 0; j < 4; ++j) {
        const int dlt = sp - (s0 + j);
        const float in = (dlt >= -rad && dlt <= rad) ? 1.f : 0.f, me = (dlt == 0) ? 1.f : 0.f;
#pragma unroll
        for (int i = 0; i < 8; ++i) { acc[j][i] += in * f[i]; ctr[j][i] += me * f[i]; }
      }
    }
#pragma unroll
    for (int j = 0; j < 4; ++j) {
      const int s = s0 + j;
      const int l2 = (s - rad < 0) ? 0 : s - rad, h2 = (s + rad + 1 > S) ? S : s + rad + 1;
      const float inv = 1.0f / (float)(h2 - l2);
      uint4 o;
      o.x = pack2(acc[j][0] * inv - ctr[j][0], acc[j][1] * inv - ctr[j][1]);
      o.y = pack2(acc[j][2] * inv - ctr[j][2], acc[j][3] * inv - ctr[j][3]);
      o.z = pack2(acc[j][4] * inv - ctr[j][4], acc[j][5] * inv - ctr[j][5]);
      o.w = pack2(acc[j][6] * inv - ctr[j][6], acc[j][7] * inv - ctr[j][7]);
      *(uint4*)(dd + (size_t)(t0 + j) * DM + c) = o;
    }
  }
}

#define XB_TMO      128
#define XB_XCNT(j)  (256  + 64 * (j))
#define XB_XSUB(j)  (1280 + 64 * (j))
#define XB_XGEN(j)  (2304 + 64 * (j))
#define XB_TOP      3328
#define XB_TOPGEN   3392
#define XCD_BAR_WORDS 3456
#define XB_SPIN_CAP (1u << 24)
__device__ __forceinline__ unsigned xb_ld(unsigned* p)              { return __hip_atomic_load(p, __ATOMIC_RELAXED, __HIP_MEMORY_SCOPE_AGENT); }
__device__ __forceinline__ unsigned xb_add(unsigned* p, unsigned v) { return __hip_atomic_fetch_add(p, v, __ATOMIC_RELAXED, __HIP_MEMORY_SCOPE_AGENT); }
__device__ __forceinline__ unsigned xb_xcc_id() { return (unsigned)__builtin_amdgcn_s_getreg((3 << 11) | 20) & 0xFu; }
#define XB_SPIN(cond, bar) do { unsigned _sp = 0; while (cond) { __builtin_amdgcn_s_sleep(1); \
    if ((++_sp & 255u) == 0u) { if (xb_ld(&(bar)[XB_TMO])) break; if (_sp > XB_SPIN_CAP) { atomicAdd(&(bar)[XB_TMO], 1u); break; } } } } while (0)
struct XcdBarrier { unsigned* bar; unsigned x; volatile __attribute__((address_space(3))) unsigned* st; };
__device__ __forceinline__ XcdBarrier xcd_barrier_post(int g_wv, unsigned* bar, volatile __attribute__((address_space(3))) unsigned* st) {
  XcdBarrier b; b.bar = bar; b.x = xb_xcc_id(); b.st = st;
  if (tid_opaque() == 0) (void)xb_add(&bar[XB_XCNT(b.x)], 1u);
  return b;
}
__device__ __forceinline__ void xcd_barrier_complete(unsigned* bar, unsigned x, unsigned& nloc, unsigned& nx) {
  const unsigned G = gridDim.x * gridDim.y * gridDim.z;
  unsigned sum, cnt, mine, sp = 0u;
  for (;;) {
    sum = 0u; cnt = 0u; mine = 0u;
#pragma unroll
    for (unsigned j = 0; j < 16; ++j) { const unsigned c = xb_ld(&bar[XB_XCNT(j)]); sum += c; cnt += (c > 0u) ? 1u : 0u; mine = (j == x) ? c : mine; }
    if (sum == G) break;
    __builtin_amdgcn_s_sleep(1);
    if ((++sp & 255u) == 0u) { if (xb_ld(&bar[XB_TMO])) break; if (sp > XB_SPIN_CAP) { atomicAdd(&bar[XB_TMO], 1u); break; } }
  }
  nloc = mine > 0u ? mine : 1u; nx = cnt > 0u ? cnt : 1u;
}
__device__ __forceinline__ void xcd_barrier(int g_wv, const XcdBarrier& b) {
  asm volatile("s_waitcnt vmcnt(0)" ::: "memory");
  __syncthreads();
  if (tid_opaque() == 0) {
    unsigned* bar = b.bar;
    __builtin_amdgcn_s_waitcnt(0);
    unsigned nloc = b.st[0], nx = b.st[1];
    if (nloc == 0u) { xcd_barrier_complete(bar, b.x, nloc, nx); b.st[0] = nloc; b.st[1] = nx; }
    const unsigned old = xb_add(&bar[XB_XSUB(b.x)], 1u);
    const unsigned gen = old / nloc;
    if (old + 1u == (gen + 1u) * nloc) {
      __builtin_amdgcn_fence(__ATOMIC_RELEASE, "agent");
      asm volatile("s_waitcnt vmcnt(0)" ::: "memory");
      const unsigned og = xb_add(&bar[XB_TOP], 1u);
      const unsigned tg = og / nx;
      if (og + 1u == (tg + 1u) * nx) xb_add(&bar[XB_TOPGEN], 1u);
      else XB_SPIN(xb_ld(&bar[XB_TOPGEN]) == tg, bar);
      __builtin_amdgcn_fence(__ATOMIC_ACQUIRE, "agent");
      xb_add(&bar[XB_XGEN(b.x)], 1u);
      asm volatile("s_waitcnt vmcnt(0)" ::: "memory");
    } else {
      XB_SPIN(xb_ld(&bar[XB_XGEN(b.x)]) == gen, bar);
      __builtin_amdgcn_fence(__ATOMIC_ACQUIRE, "agent");
      asm volatile("s_waitcnt vmcnt(0)" ::: "memory");
    }
  }
  __syncthreads();
}

__global__ void __launch_bounds__(512) mega(Params P) {
  cg::grid_group grid = cg::this_grid();
  const int g_wv = __builtin_amdgcn_readfirstlane((int)(threadIdx.x >> 6));
  extern __shared__ __attribute__((aligned(16))) char smem[];
  __shared__ uint4 xb_words;
  if (tid_opaque() == 0) xb_words = make_uint4(0u, 0u, 0u, 0u);
  __syncthreads();
  XcdBarrier xb = xcd_barrier_post(g_wv, (unsigned*)(P.ws + OFF_BAR), (volatile __attribute__((address_space(3))) unsigned*)&xb_words);
  char* ws = P.ws;
  bf16_t* Wb = (bf16_t*)(ws + OFF_W);
  float2* rot = (float2*)(ws + OFF_ROT);

  for (int j = 0; j < 2; ++j) {
    bf16_t* we = Wb + WOFF_EVEN + (size_t)j * W_EVEN;
    transpose_w(g_wv, P.in[4] + (size_t)j * DM * AB_IN, DM, AB_IN, we, DM, 0, smem);
    for (int e = blockIdx.x * NT + tid_opaque(); e < (AB_PAD - AB_IN) * DM / 8; e += gridDim.x * NT) { unsigned z = 0; asm volatile("" : "+v"(z)); *(uint4*)(we + (size_t)AB_IN * DM + (size_t)e * 8) = make_uint4(z, z, z, z); }
    transpose_w(g_wv, P.in[5] + (size_t)j * AB_OUT * DM, AB_OUT, DM, we + W_AB, AB_OUT, 0, smem);
    build_lora(g_wv, P.in[8] + (size_t)j * 2 * 64 * RW, P.in[10] + (size_t)j * 2 * 64 * RW, P.in[11] + (size_t)j * 128 * RW, we + W_AB + W_ABO);
    bf16_t* wo = Wb + WOFF_ODD + (size_t)j * W_ODD;
    transpose_w(g_wv, P.in[17] + (size_t)j * DM * DM, DM, DM, wo, DM, 0, smem);
    for (int g = 0; g < 4; ++g) transpose_w(g_wv, P.in[18] + ((size_t)j * 4 + g) * 256 * 256, 256, 256, wo + W_CIN + (size_t)g * 256 * 256, 256, 0, smem);
    transpose_w(g_wv, P.in[20] + (size_t)j * DM * DM, DM, DM, wo + W_CIN + W_GRP, DM, 0, smem);
  }
  for (int i = 0; i < 4; ++i) {
    bf16_t* wl = Wb + WOFF_LAYER + (size_t)i * W_LAYER;
    transpose_w(g_wv, P.in[25] + (size_t)i * DM * UP, DM, UP, wl, DM, 1, smem);
    transpose_w(g_wv, P.in[28] + (size_t)i * DFF * DM, DFF, DM, wl + W_UP, DFF, 0, smem);
    transpose_w(g_wv, P.in[30] + (size_t)i * DM * DM, DM, DM, wl + W_UP + W_DOWN, DM, 0, smem);
    transpose_w(g_wv, P.in[29] + (size_t)i * PLE * DM, PLE, DM, wl + W_UP + W_DOWN + W_GATE, PLE, 0, smem);
  }
  build_rotary(g_wv, rot);
  grid.sync();

  bf16_t* hb = (bf16_t*)(ws + OFF_A + HB_HALO);
  bf16_t* z1 = (bf16_t*)(ws + OFF_Z1);
  bf16_t* z2 = (bf16_t*)(ws + OFF_Z2);
  bf16_t* yab = (bf16_t*)(ws + OFF_Y);
  bf16_t* pb = (bf16_t*)(ws + OFF_Y);
  bf16_t* rkv = (bf16_t*)(ws + OFF_RKV);
  float* opart = (float*)(ws + OFF_RKV);
  float* lsep = (float*)(ws + OFF_LSE);
  bf16_t* Lb = (bf16_t*)(ws + OFF_L);
  bf16_t* gbuf = (bf16_t*)(ws + OFF_G);
  bf16_t* ea = (bf16_t*)(ws + OFF_Z2);
  bf16_t* ypb = (bf16_t*)(ws + OFF_YP);
  float* Qb = (float*)(ws + OFF_SQ);
  float* Mb = (float*)(ws + OFF_SM);
  float* Sib = (float*)(ws + OFF_SI);
  bf16_t* act = (bf16_t*)(ws + OFF_Z1);
  bf16_t* ub = (bf16_t*)(ws + OFF_Z1);
  bf16_t* db = (bf16_t*)(ws + OFF_Z2);
  bf16_t* ygb = (bf16_t*)(ws + OFF_RKV);
  bf16_t* hb2 = (bf16_t*)(ws + OFF_RKV);
  float* knb = (float*)(ws + OFF_KN);
  bf16_t* edgeb = (bf16_t*)(ws + OFF_EDGE);
  float* ps0 = (float*)(ws + OFF_PS);
  float* ps1 = ps0 + (size_t)TG * 16;
  float* ps2 = ps1 + (size_t)TG * 16;

#ifndef PROBE_A
#define PROBE_A -1
#endif
#ifndef PROBE_B
#define PROBE_B -1
#endif
  unsigned long long accA = 0, accB = 0;
#define PH(cat, ...)                                                                   \
  {                                                                                    \
    unsigned long long t0_ = 0;                                                        \
    if ((cat) == PROBE_A || (cat) == PROBE_B || (PROBE_A == 100 && (cat) >= 10)) t0_ = wall_clock64();                    \
    __VA_ARGS__;                                                                       \
    xcd_barrier(g_wv, xb);                                                             \
    if (PROBE_A == 99) xcd_barrier(g_wv, xb);                                          \
    if ((cat) == PROBE_A || (PROBE_A == 100 && (cat) >= 10)) accA += wall_clock64() - t0_;                                \
    if ((cat) == PROBE_B) accB += wall_clock64() - t0_;                                \
  }
  for (int grp = 0; grp < 2; ++grp) {
    const int B = grp ? 16 : 2, S = grp ? 2048 : 16384;
    const float* xin = P.in[grp];
    const float* pin = P.in[2 + grp];
    float* xo = P.out + (size_t)grp * TG * DM;
    for (int layer = 0; layer < DEPTH; ++layer) {
      const int j = layer >> 1;
      const float* xcur = layer ? xo : xin;
      const bf16_t* wl = Wb + WOFF_LAYER + (size_t)layer * W_LAYER;
      const bf16_t* amix = layer ? hb2 : hb;
      const float* psmix = layer ? ps2 : nullptr;
      if (layer == 0) PH(3, ph_rmsnorm(g_wv, xcur, P.in[21] + layer * DM, hb, TG, nullptr, nullptr));
      if ((layer & 1) == 0) {
        const bf16_t* we = Wb + WOFF_EVEN + (size_t)j * W_EVEN;
        PH(10, ph_gemm_ab(g_wv, amix, we, z1, z2, psmix, smem));
        PH(2, ph_attention(g_wv, z2, rot, opart, lsep, B, S, smem));
        PH(2, ph_attn_combine(g_wv, opart, lsep, yab));
        PH(3, ph_rwkv_prep(g_wv, z1, P.in[6] + j * RWKV_IN, rkv, Lb, S, P.in[12] + j * RW, knb));
        PH(11, ph_gemm_lora(g_wv, Lb, we + W_AB + W_ABO, P.in[7] + j * 1024, P.in[9] + j * 1024, ea, gbuf, smem));
        PH(1, ph_scan_pass1(g_wv, rkv, ea, knb, P.in[12] + j * RW, P.in[13] + j * RW, Qb, Mb, B, S, smem));
        PH(1, ph_scan_pass2(g_wv, Qb, Mb, Sib, B, S, smem));
        PH(1, ph_scan_pass3(g_wv, rkv, ea, knb, P.in[12] + j * RW, P.in[13] + j * RW, Sib, ypb, B, S, smem));
        PH(3, ph_rwkv_post(g_wv, ypb, rkv, ea, gbuf, P.in[13] + j * RW, P.in[14] + j * RW, P.in[15] + j * RW, P.in[16] + j * RW, yab));
        PH(12, zero_hb_halo(g_wv, hb, TG); ph_gemm_res(g_wv, yab, AB_OUT, we + W_AB, xcur, xo, P.in[22] + layer * DM, hb, ps0, smem));
      } else {
        const bf16_t* wo = Wb + WOFF_ODD + (size_t)j * W_ODD;
        PH(16, ph_gemm_bf16(g_wv, amix, DM, DM, 0, wo, nullptr, ub, psmix, smem));
        PH(3, ph_pool(g_wv, ub, db, S));
        PH(16, ph_gemm_bf16(g_wv, db, DM, 256, 1, wo + W_CIN, P.in[19] + j * DM, ygb, nullptr, smem));
        PH(16, zero_hb_halo(g_wv, hb, TG); ph_gemm_res(g_wv, ygb, DM, wo + W_CIN + W_GRP, xcur, xo, P.in[22] + layer * DM, hb, ps0, smem));
      }
      PH(13, ph_ffn_up(g_wv, hb, wl, P.in[26] + (size_t)layer * 3 * UP, P.in[27] + (size_t)layer * UP, act, B, S, ps0, pin + (size_t)layer * TG * PLE, pb, edgeb, smem));
      PH(3, ph_ffn_edges(g_wv, edgeb, P.in[26] + (size_t)layer * 3 * UP, P.in[27] + (size_t)layer * UP, act, S));
      PH(14, ph_gemm_res(g_wv, act, DFF, wl + W_UP, xo, xo, P.in[23] + layer * DM, hb, ps1, smem));
      PH(15, ph_ple(g_wv, hb, wl + W_UP + W_DOWN, P.in[31] + layer * DM, pb, wl + W_UP + W_DOWN + W_GATE, z1, xo, ps1,
                    P.in[21] + ((layer + 1 < DEPTH) ? (layer + 1) : layer) * DM, (layer + 1 < DEPTH) ? hb2 : nullptr, ps2, smem));
    }
    ph_final_norm(g_wv, xo, P.in[24], TG);
  }
#if PROBE_A >= 0
  if (blockIdx.x == 0 && tid_opaque() == 0) {
    unsigned long long wait = accA + accB;
    unsigned long long ts = wall_clock64();
    while (wall_clock64() - ts < wait) __builtin_amdgcn_s_sleep(32);
  }
#endif
}

extern "C" void kernel_launch(void* const* d_in, const int* in_sizes, int n_in, void* d_out, int out_size, void* d_ws, size_t ws_size, hipStream_t stream) {
  static int grid_blocks = 0;
  if (!grid_blocks) {
    int dev = 0, cus = 0, per_cu = 0;
    (void)hipGetDevice(&dev);
    (void)hipDeviceGetAttribute(&cus, hipDeviceAttributeMultiprocessorCount, dev);
    (void)hipFuncSetAttribute((const void*)mega, hipFuncAttributeMaxDynamicSharedMemorySize, SMEM_BYTES);
    (void)hipOccupancyMaxActiveBlocksPerMultiprocessor(&per_cu, (const void*)mega, NT, SMEM_BYTES);
    if (per_cu < 1) per_cu = 1;
    if (per_cu > 1) per_cu = 1;
    grid_blocks = cus * per_cu;
    if (ws_size < WS_NEED) fprintf(stderr, "kernel_launch: workspace too small: %zu < %zu\n", ws_size, (size_t)WS_NEED);
  }
  if (ws_size < WS_NEED || n_in != 32) return;
  Params p{};
  for (int i = 0; i < 32; ++i) p.in[i] = (const float*)d_in[i];
  p.out = (float*)d_out;
  p.ws = (char*)d_ws;
  (void)hipMemsetAsync((char*)d_ws + OFF_BAR, 0, SZ_BAR, stream);
  void* args[] = {&p};
  hipError_t e = hipLaunchCooperativeKernel((const void*)mega, dim3(grid_blocks), dim3(NT), args, SMEM_BYTES, stream);
  if (e != hipSuccess) fprintf(stderr, "cooperative launch failed: %s (grid %d)\n", hipGetErrorString(e), grid_blocks);
}
```

```cpp
#include <hip/hip_runtime.h>
#include <hip/hip_cooperative_groups.h>
#include <cstdio>
namespace cg = cooperative_groups;

typedef unsigned short bf16_t;
typedef short bf16x8 __attribute__((ext_vector_type(8)));
typedef float f32x4 __attribute__((ext_vector_type(4)));

constexpr int DM = 1024, DEPTH = 4, PLE = 256;
constexpr int RW = 512, RWKV_IN = 1920, ATT_IN = 2304, AB_IN = 4224, AB_OUT = 768;
constexpr int DFF = 2816, UP = 5632;
constexpr int TG = 32768;
constexpr int NLORA = 2560, KLORA = 384;
constexpr int CHUNK_L = 512;
constexpr int TB = 4;
constexpr int NT = 512, NW = 8;
constexpr int AB_PAD = 4352;

constexpr size_t W_AB = (size_t)AB_PAD * DM, W_ABO = (size_t)DM * AB_OUT, W_LORA = (size_t)NLORA * KLORA;
constexpr size_t W_EVEN = W_AB + W_ABO + W_LORA;
constexpr size_t W_CIN = (size_t)DM * DM, W_GRP = (size_t)DM * 256, W_COUT = (size_t)DM * DM;
constexpr size_t W_ODD = W_CIN + W_GRP + W_COUT;
constexpr size_t W_UP = (size_t)UP * DM, W_DOWN = (size_t)DM * DFF, W_GATE = (size_t)DM * DM, W_PROJ = (size_t)DM * PLE;
constexpr size_t W_LAYER = W_UP + W_DOWN + W_GATE + W_PROJ;
constexpr size_t WOFF_EVEN = 0, WOFF_ODD = 2 * W_EVEN, WOFF_LAYER = WOFF_ODD + 2 * W_ODD;
constexpr size_t W_TOTAL = WOFF_LAYER + 4 * W_LAYER;

constexpr size_t al256(size_t x) { return (x + 255) / 256 * 256; }
constexpr size_t OFF_W = 0;
constexpr size_t OFF_A = al256(W_TOTAL * 2);
constexpr size_t HB_HALO = (size_t)256 * DM * 2;
constexpr size_t SZ_A = (size_t)TG * DM * 2 + 2 * HB_HALO;
constexpr size_t OFF_Z1 = OFF_A + SZ_A;
constexpr size_t SZ_Z1 = (size_t)TG * RWKV_IN * 2;
constexpr size_t OFF_Z2 = OFF_Z1 + SZ_Z1;
constexpr size_t SZ_Z2 = (size_t)TG * ATT_IN * 2;
constexpr size_t OFF_Y = OFF_Z2 + SZ_Z2;
constexpr size_t SZ_Y = (size_t)TG * AB_OUT * 2;
constexpr size_t OFF_RKV = OFF_Y + SZ_Y;
constexpr size_t SZ_RKV = (size_t)TG * 1536 * 2;
constexpr size_t OFF_ROT = OFF_RKV + SZ_RKV;
constexpr size_t SZ_ROT = (size_t)16384 * 8 * 8;
constexpr size_t OFF_LSE = OFF_ROT + SZ_ROT;
constexpr size_t SZ_LSE = (size_t)3 * TG * 4 * 4;
constexpr size_t OFF_PS = OFF_LSE + SZ_LSE;
constexpr size_t SZ_PS = (size_t)3 * TG * 16 * 4;
constexpr size_t OFF_BAR = OFF_PS + SZ_PS;
constexpr size_t SZ_BAR = 3456 * 4;
constexpr size_t OFF_KN = OFF_BAR + al256(SZ_BAR);
constexpr size_t SZ_KN = (size_t)TG * 8 * 4;
constexpr size_t OFF_EDGE = OFF_KN + SZ_KN;
constexpr size_t SZ_EDGE = (size_t)(TG / 256) * 4 * UP * 2;
constexpr size_t WS_NEED = OFF_EDGE + SZ_EDGE;
constexpr size_t OFF_L = OFF_A;
constexpr size_t OFF_G = OFF_A + al256((size_t)TG * KLORA * 2);
constexpr size_t OFF_YP = OFF_Z1;
constexpr size_t OFF_SQ = OFF_Z1 + (size_t)2 * TG * RW * 2;
constexpr size_t OFF_SM = OFF_SQ + (size_t)1024 * 4096 * 4;
constexpr size_t OFF_SI = OFF_SM + (size_t)1024 * 4096 * 4;
static_assert(OFF_SI + (size_t)1024 * 4096 * 4 <= OFF_Z2, "scan states overflow Z1");
static_assert((size_t)TG * KLORA * 2 + (size_t)TG * RW * 2 + 256 <= SZ_A - HB_HALO, "L+g overflow A");
static_assert((size_t)3 * TG * 256 * 4 <= SZ_RKV, "o_part overflow");

struct Params { const float* in[32]; float* out; char* ws; };

__device__ __forceinline__ bf16_t f2bf(float f) {
  unsigned u = __float_as_uint(f);
  u += 0x7fffu + ((u >> 16) & 1u);
  return (bf16_t)(u >> 16);
}
__device__ __forceinline__ float bf2f(bf16_t h) { return __uint_as_float(((unsigned)h) << 16); }
__device__ __forceinline__ unsigned pack2(float a, float b) { return (unsigned)f2bf(a) | ((unsigned)f2bf(b) << 16); }
__device__ __forceinline__ float lo2f(unsigned u) { return __uint_as_float(u << 16); }
__device__ __forceinline__ float hi2f(unsigned u) { return __uint_as_float(u & 0xffff0000u); }
__device__ __forceinline__ void unpack8(const uint4& u, float (&f)[8]) {
  f[0] = lo2f(u.x); f[1] = hi2f(u.x); f[2] = lo2f(u.y); f[3] = hi2f(u.y); f[4] = lo2f(u.z); f[5] = hi2f(u.z); f[6] = lo2f(u.w); f[7] = hi2f(u.w);
}
__device__ __forceinline__ int tid_from_wave(int wv) { unsigned z = 0; asm volatile("" : "+v"(z));   int t = wv * 64 + (int)__builtin_amdgcn_mbcnt_hi(~0u, __builtin_amdgcn_mbcnt_lo(~0u, z)); return t; }
#define tid_opaque() tid_from_wave(g_wv)
__device__ __forceinline__ float wave_sum(float v) {
#pragma unroll
  for (int o = 32; o > 0; o >>= 1) v += __shfl_xor(v, o, 64);
  return v;
}
__device__ __forceinline__ float sigmoidf_(float x) { return 1.0f / (1.0f + __expf(-x)); }
__device__ __forceinline__ float tanhf_(float x) {
  float ax = fabsf(x);
  float e = __expf(-2.0f * ax);
  float t = (1.0f - e) / (1.0f + e);
  return x < 0.f ? -t : t;
}
__device__ __forceinline__ float gelu_tanh(float x) {
  float y = 0.7978845608028654f * (x + 0.044715f * x * x * x);
  return 0.5f * x * (1.0f + tanhf_(y));
}

__device__ __forceinline__ void transpose_w(int g_wv, const float* __restrict__ src, int K, int N, bf16_t* __restrict__ dst, int ldk, int mode, char* smem) {
  float* tile = (float*)smem;
  const int tid = tid_opaque();
  const int tk = K / 64, tn = N / 64;
  for (int t = blockIdx.x; t < tk * tn; t += gridDim.x) {
    int k0 = (t / tn) * 64, n0 = (t % tn) * 64;
    __syncthreads();
    if (tid < 256) {
#pragma unroll
    for (int i = 0; i < 4; ++i) {
      int r = (tid >> 4) + 16 * i, c4 = (tid & 15) * 4;
      float4 v = *(const float4*)(src + (size_t)(k0 + r) * N + n0 + c4);
      tile[r * 65 + c4 + 0] = v.x; tile[r * 65 + c4 + 1] = v.y; tile[r * 65 + c4 + 2] = v.z; tile[r * 65 + c4 + 3] = v.w;
    }
    }
    __syncthreads();
    if (tid >= 256) continue;
    int nl = tid >> 2, ks = (tid & 3) * 16;
    int n = n0 + nl;
    int drow = n;
    if (mode == 1) { int c = (n < DFF) ? n : n - DFF; drow = (c >> 7) * 256 + ((n < DFF) ? 0 : 128) + (c & 127); }
    unsigned o[8];
#pragma unroll
    for (int j = 0; j < 8; ++j) o[j] = pack2(tile[(ks + 2 * j) * 65 + nl], tile[(ks + 2 * j + 1) * 65 + nl]);
    uint4* dp = (uint4*)(dst + (size_t)drow * ldk + k0 + ks);
    dp[0] = make_uint4(o[0], o[1], o[2], o[3]);
    dp[1] = make_uint4(o[4], o[5], o[6], o[7]);
  }
}

__device__ __forceinline__ void build_lora(int g_wv, const float* __restrict__ w_up, const float* __restrict__ a_up, const float* __restrict__ g_up, bf16_t* __restrict__ dst) {
  const int total = NLORA * 256;
  for (int e = blockIdx.x * NT + tid_opaque(); e < total; e += gridDim.x * NT) {
    int k = e / NLORA, n = e - k * NLORA;
    int nb = n >> 9, nl = n & 511;
    float v = 0.f;
    if (nb < 2) { int kk = k - 64 * nb; if (kk >= 0 && kk < 64) v = w_up[((size_t)nb * 64 + kk) * 512 + nl]; }
    else if (nb < 4) { int d = nb - 2; int kk = k - 128 - 64 * d; if (kk >= 0 && kk < 64) v = a_up[((size_t)d * 64 + kk) * 512 + nl]; }
    else { int kk = k - 128; if (kk >= 0 && kk < 128) v = g_up[(size_t)kk * 512 + nl]; }
    dst[(size_t)n * 256 + k] = f2bf(v);
  }
}

__device__ __forceinline__ void build_rotary(int g_wv, float2* __restrict__ rot) {
  const float invf[8] = {1.0f, 0.1939227432012558f, 0.03760603070259094f, 0.007292664609849453f, 0.0014142135623842478f,
                         0.00027424818836152554f, 5.318296098266728e-05f, 1.0313386155758053e-05f};
  for (int e = blockIdx.x * NT + tid_opaque(); e < 16384 * 8; e += gridDim.x * NT) {
    int s = e >> 3, i = e & 7;
    float inv = invf[0];
#pragma unroll
    for (int q = 1; q < 8; ++q) inv = (i == q) ? invf[q] : inv;
    float angf = (float)s * inv;
    double a = (double)angf;
    double rev = a * 0.15915494309189535;
    rev -= rint(rev);
    double x = rev * 6.283185307179586;
    double x2 = x * x;
    double sn = 0.0, cs = 0.0;
    {
      double t = 1.0; cs = 1.0;
#pragma unroll
      for (int n = 1; n <= 13; ++n) { t = -t * x2 / (double)((2 * n - 1) * (2 * n)); cs += t; }
      double u = x; sn = x;
#pragma unroll
      for (int n = 1; n <= 13; ++n) { u = -u * x2 / (double)((2 * n) * (2 * n + 1)); sn += u; }
    }
    rot[e] = make_float2((float)cs, (float)sn);
  }
}

__device__ __forceinline__ void ph_rmsnorm(int g_wv, const float* __restrict__ x, const float* __restrict__ g, bf16_t* __restrict__ hb, int T,
                           const float* __restrict__ p, bf16_t* __restrict__ pb, bool zero_halo = false) {
  const int lane = tid_opaque() & 63, wv = __builtin_amdgcn_readfirstlane(tid_opaque() >> 6);
  if (zero_halo) {
    for (int e = blockIdx.x * NT + tid_opaque(); e < 257 * (DM / 8); e += gridDim.x * NT) {
      int r = e / (DM / 8), c = (e - r * (DM / 8)) * 8;
      long row = (r == 0) ? -1 : (long)T + r - 1;
      unsigned z = 0; asm volatile("" : "+v"(z));
      *(uint4*)(hb + row * DM + c) = make_uint4(z, z, z, z);
    }
  }
  float4 gv[4];
#pragma unroll
  for (int i = 0; i < 4; ++i) gv[i] = *(const float4*)(g + 4 * lane + 256 * i);
  for (int row = blockIdx.x * NW + wv; row < T; row += gridDim.x * NW) {
    const float* xr = x + (size_t)row * DM;
    float4 v[4];
    float ss = 0.f;
#pragma unroll
    for (int i = 0; i < 4; ++i) { v[i] = *(const float4*)(xr + 4 * lane + 256 * i); ss += v[i].x * v[i].x + v[i].y * v[i].y + v[i].z * v[i].z + v[i].w * v[i].w; }
    ss = wave_sum(ss);
    float rs = rsqrtf(ss * (1.0f / DM) + 1e-6f);
#pragma unroll
    for (int i = 0; i < 4; ++i) {
      uint2 o;
      o.x = pack2(v[i].x * rs * gv[i].x, v[i].y * rs * gv[i].y);
      o.y = pack2(v[i].z * rs * gv[i].z, v[i].w * rs * gv[i].w);
      *(uint2*)(hb + (size_t)row * DM + 4 * lane + 256 * i) = o;
    }
    if (p) {
      float4 pv = *(const float4*)(p + (size_t)row * PLE + 4 * lane);
      uint2 o; o.x = pack2(pv.x, pv.y); o.y = pack2(pv.z, pv.w);
      *(uint2*)(pb + (size_t)row * PLE + 4 * lane) = o;
    }
  }
}
__device__ __forceinline__ void zero_hb_halo(int g_wv, bf16_t* hb, int T) {
  for (int e = blockIdx.x * NT + tid_opaque(); e < 257 * (DM / 8); e += gridDim.x * NT) {
    int r = e / (DM / 8), c = (e - r * (DM / 8)) * 8;
    long row = (r == 0) ? -1 : (long)T + r - 1;
    unsigned z = 0; asm volatile("" : "+v"(z));
    *(uint4*)(hb + row * DM + c) = make_uint4(z, z, z, z);
  }
}
__device__ __forceinline__ void ph_final_norm(int g_wv, float* __restrict__ x, const float* __restrict__ g, int T) {
  const int lane = tid_opaque() & 63, wv = __builtin_amdgcn_readfirstlane(tid_opaque() >> 6);
  for (int row = blockIdx.x * NW + wv; row < T; row += gridDim.x * NW) {
    float* xr = x + (size_t)row * DM;
    float4 v[4];
    float ss = 0.f;
#pragma unroll
    for (int i = 0; i < 4; ++i) { v[i] = *(const float4*)(xr + 4 * lane + 256 * i); ss += v[i].x * v[i].x + v[i].y * v[i].y + v[i].z * v[i].z + v[i].w * v[i].w; }
    ss = wave_sum(ss);
    float rs = rsqrtf(ss * (1.0f / DM) + 1e-6f);
#pragma unroll
    for (int i = 0; i < 4; ++i) {
      float4 gg = *(const float4*)(g + 4 * lane + 256 * i);
      float4 o = make_float4(v[i].x * rs * gg.x, v[i].y * rs * gg.y, v[i].z * rs * gg.z, v[i].w * rs * gg.w);
      *(float4*)(xr + 4 * lane + 256 * i) = o;
    }
  }
}

#define PG8_LAS __attribute__((address_space(3)))
constexpr int BK = 64, HALF = 128, HTB = HALF * BK * 2, SMEM_BYTES = 8 * HTB;
__device__ __forceinline__ int lds_byte(int r, int c) { const int st = (r >> 4) * 2 + (c >> 5), rr = r & 15, cc = c & 31, ob = rr * 64 + cc * 2; return st * 1024 + (ob ^ (((ob >> 9) & 1) << 5)); }
__device__ __forceinline__ void stage_rc(int b, int& R, int& C) { const int st = b / 1024, sb = b % 1024, swz = sb ^ (((sb >> 9) & 1) << 5); R = (st >> 1) * 16 + swz / 64; C = (st & 1) * 32 + (swz % 64) / 2; }
struct Unit { int pm, pn; long aoff; };
struct Gemm { const bf16_t* A; const bf16_t* Bt; int lda; int K; };

__device__ __forceinline__ int tile_remap(int t, int ntiles) {
  int G = gridDim.x;
  int it = t / G;
  if ((G & 7) == 0 && (it + 1) * G <= ntiles) {
    int b = t - it * G;
    return it * G + (b & 7) * (G >> 3) + (b >> 3);
  }
  return t;
}
__device__ __forceinline__ void tile_map(int t0, int nt_m, int nt_n, int bw, int& tm, int& tn) {
  asm volatile("" : "+s"(nt_m), "+s"(nt_n), "+s"(bw));
  int lt = tile_remap(t0, nt_m * nt_n);
  int full = nt_m * bw;
  int nr = (nt_n + bw - 1) / bw;
  int r = lt / full;
  if (r > nr - 1) r = nr - 1;
  int rem = lt - r * full;
  int width = (r == nr - 1) ? (nt_n - r * bw) : bw;
  tm = rem / width;
  tn = r * bw + (rem - tm * width);
}
struct TileSched {
  int nt_m, nt_n, bw, lda, rowstep, rowoff, acolstep, acol_from, acol_add;
  __device__ __forceinline__ void fill(int t0, Unit& u) const {
    int tm, tn; tile_map(t0, nt_m, nt_n, bw, tm, tn);
    u.pm = tm; u.pn = tn;
    u.aoff = (((long)tm * rowstep + rowoff) * lda + (long)tn * acolstep + ((acol_add && tn >= acol_from) ? acol_add : 0)) * 2;
  }
  __device__ __forceinline__ bool next(int i, Unit& u) const {
    const int t0 = blockIdx.x + i * gridDim.x;
    if (t0 >= nt_m * nt_n) return false;
    fill(t0, u);
    return true;
  }
};
struct OneUnit {
  Unit u;
  __device__ __forceinline__ bool next(int i, Unit& o) const { if (i) return false; o = u; return true; }
};

template <class Epi, class Sched>
__device__ __forceinline__ void gemm_phase(int g_wv, PG8_LAS unsigned char* lds, const Gemm g, const Sched& S, const Epi& E) {
  const int tid = tid_opaque(), wid = __builtin_amdgcn_readfirstlane(tid >> 6), lane = tid & 63, wr = wid >> 2, wc = wid & 3, fr = lane & 15, fq = lane >> 4;
  const int K = g.K, nt = K / BK;
  unsigned voffA[2], voffB[2];
#pragma unroll
  for (int i = 0; i < 2; ++i) { int R, C; stage_rc(tid * 16 + i * 8192, R, C); voffA[i] = (unsigned)(R * g.lda + C) * 2u; voffB[i] = (unsigned)(R * K + C) * 2u; }
  const size_t kstep = (size_t)(BK * 2);
  const size_t hstepA = (size_t)HALF * g.lda * 2, hstepB = (size_t)HALF * K * 2;
  const size_t tstepB = 2 * hstepB;
  const unsigned ldsw = (unsigned)wid * 1024u;
  const int aoff = lds_byte(wr * 64 + fr, fq * 8), boff = lds_byte(wc * 32 + fr, fq * 8);
#define PG8_SA(b, h) (((b) * 2 + (h)) * HTB)
#define PG8_SB(b, h) ((4 + (b) * 2 + (h)) * HTB)
#define PG8_STAGE(bufoff, gbase, voff) do { _Pragma("unroll") for (int _i = 0; _i < 2; ++_i) \
    __builtin_amdgcn_global_load_lds((const unsigned*)((const char*)(gbase) + (voff)[_i]), (PG8_LAS unsigned*)(lds + (bufoff) + ldsw + _i * 8192), 16, 0, 0); } while (0)
#define PG8_LDA(dst, b, h) do { _Pragma("unroll") for (int m = 0; m < 4; ++m) _Pragma("unroll") for (int k = 0; k < 2; ++k) dst[m][k] = *(const PG8_LAS bf16x8*)(lds + PG8_SA(b, h) + aoff + m * 2048 + k * 1024); } while (0)
#define PG8_LDB(dst, b, h) do { _Pragma("unroll") for (int n = 0; n < 2; ++n) _Pragma("unroll") for (int k = 0; k < 2; ++k) dst[n][k] = *(const PG8_LAS bf16x8*)(lds + PG8_SB(b, h) + boff + n * 2048 + k * 1024); } while (0)
#define PG8_MMA(ai, bj, At, Bt) do { __builtin_amdgcn_s_setprio(1); _Pragma("unroll") for (int m = 0; m < 4; ++m) _Pragma("unroll") for (int n = 0; n < 2; ++n) _Pragma("unroll") for (int k = 0; k < 2; ++k) \
    acc[ai][bj][m][n] = __builtin_amdgcn_mfma_f32_16x16x32_bf16(Bt[n][k], At[m][k], acc[ai][bj][m][n], 0, 0, 0); __builtin_amdgcn_s_setprio(0); } while (0)
#define PG8_WAIT_V(n) asm volatile("s_waitcnt vmcnt(" #n ")" ::: "memory")
#define PG8_WAIT_L(n) asm volatile("s_waitcnt lgkmcnt(" #n ")" ::: "memory")
#define PG8_BAR __builtin_amdgcn_s_barrier()
#define PG8_SCHED __builtin_amdgcn_sched_barrier(0)
  Unit cur, nxt; int ui = 0;
  if (!S.next(0, cur)) return;
  f32x4 acc[2][2][4][2];
#pragma unroll
  for (int a = 0; a < 2; ++a)
#pragma unroll
    for (int b = 0; b < 2; ++b)
#pragma unroll
      for (int m = 0; m < 4; ++m)
#pragma unroll
        for (int n = 0; n < 2; ++n) acc[a][b][m][n] = (f32x4){0.f, 0.f, 0.f, 0.f};
  bf16x8 At[4][2], B0[2][2], B1[2][2];
  const char* cA = (const char*)g.A + cur.aoff; const char* cB = (const char*)g.Bt + (size_t)cur.pn * tstepB;
  PG8_STAGE(PG8_SB(0, 0), cB, voffB); PG8_STAGE(PG8_SA(0, 0), cA, voffA); PG8_STAGE(PG8_SB(0, 1), cB + hstepB, voffB); PG8_STAGE(PG8_SA(0, 1), cA + hstepA, voffA);
  if (wr == 1) PG8_BAR;
  PG8_WAIT_V(4); PG8_BAR;
  PG8_STAGE(PG8_SB(1, 0), cB + kstep, voffB); PG8_STAGE(PG8_SA(1, 0), cA + kstep, voffA); PG8_STAGE(PG8_SB(1, 1), cB + hstepB + kstep, voffB);
  PG8_WAIT_V(6); PG8_BAR;
  for (;;) {
    const bool has_next = S.next(ui + 1, nxt);
    const char* nA = has_next ? (const char*)g.A + nxt.aoff : cA; const char* nB = has_next ? (const char*)g.Bt + (size_t)nxt.pn * tstepB : cB;
#pragma unroll 1
    for (int t = 0; t < nt; t += 2) {
      const bool last = (t == nt - 2);
      const char* a1 = cA + (size_t)(t + 1) * kstep;
      const char* a2 = last ? nA : cA + (size_t)(t + 2) * kstep; const char* b2 = last ? nB : cB + (size_t)(t + 2) * kstep;
      const char* a3 = a2 + kstep; const char* b3 = b2 + kstep;
      PG8_LDB(B0, 0, 0); PG8_SCHED; PG8_LDA(At, 0, 0); PG8_STAGE(PG8_SA(1, 1), a1 + hstepA, voffA);
      PG8_WAIT_L(8); PG8_BAR; PG8_WAIT_L(0); PG8_MMA(0, 0, At, B0); PG8_BAR; PG8_SCHED;
      PG8_LDB(B1, 0, 1); PG8_STAGE(PG8_SB(0, 0), b2, voffB);
      PG8_BAR; PG8_WAIT_L(0); PG8_MMA(0, 1, At, B1); PG8_BAR;
      PG8_LDA(At, 0, 1); PG8_STAGE(PG8_SA(0, 0), a2, voffA);
      PG8_BAR; PG8_WAIT_L(0); PG8_MMA(1, 0, At, B0); PG8_BAR; PG8_SCHED;
      PG8_STAGE(PG8_SB(0, 1), b2 + hstepB, voffB);
      PG8_WAIT_V(6); PG8_BAR; PG8_MMA(1, 1, At, B1); PG8_BAR;
      PG8_LDB(B0, 1, 0); PG8_SCHED; PG8_LDA(At, 1, 0); PG8_STAGE(PG8_SA(0, 1), a2 + hstepA, voffA);
      PG8_WAIT_L(8); PG8_BAR; PG8_WAIT_L(0); PG8_MMA(0, 0, At, B0); PG8_BAR; PG8_SCHED;
      PG8_LDB(B1, 1, 1); PG8_STAGE(PG8_SB(1, 0), b3, voffB);
      PG8_BAR; PG8_WAIT_L(0); PG8_MMA(0, 1, At, B1); PG8_BAR;
      PG8_LDA(At, 1, 1); PG8_STAGE(PG8_SA(1, 0), a3, voffA);
      PG8_BAR; PG8_WAIT_L(0); PG8_MMA(1, 0, At, B0); PG8_BAR; PG8_SCHED;
      PG8_STAGE(PG8_SB(1, 1), b3 + hstepB, voffB);
      PG8_WAIT_V(6); PG8_BAR; PG8_MMA(1, 1, At, B1); PG8_BAR;
    }
    if constexpr (!Epi::AFTER_DRAIN) E(acc, cur, wr, wc, fr, fq);
    if (!has_next) break;
#pragma unroll
    for (int a = 0; a < 2; ++a)
#pragma unroll
      for (int b = 0; b < 2; ++b)
#pragma unroll
        for (int m = 0; m < 4; ++m)
#pragma unroll
          for (int n = 0; n < 2; ++n) acc[a][b][m][n] = (f32x4){0.f, 0.f, 0.f, 0.f};
    cur = nxt; cA = nA; cB = nB; ++ui;
  }
  PG8_WAIT_V(0);
  if (wr == 0) PG8_BAR;
  PG8_BAR;
  if constexpr (Epi::AFTER_DRAIN) E.fused(acc, cur, wr, wc, fr, fq, lds, wid, lane);
#undef PG8_SA
#undef PG8_SB
#undef PG8_STAGE
#undef PG8_LDA
#undef PG8_LDB
#undef PG8_MMA
#undef PG8_WAIT_V
#undef PG8_WAIT_L
#undef PG8_BAR
#undef PG8_SCHED
}

#define EPI_ROWS _Pragma("unroll") for (int ai = 0; ai < 2; ++ai) _Pragma("unroll") for (int m = 0; m < 4; ++m)
#define EPI_COLS _Pragma("unroll") for (int bj = 0; bj < 2; ++bj) _Pragma("unroll") for (int n = 0; n < 2; ++n)
#define EPI_FENCE __builtin_amdgcn_sched_barrier(0)
#define EPI_FOR  EPI_ROWS EPI_COLS
#define EPI_ROW (128 * ai + 64 * wr + 16 * m + fr)
#define EPI_COL (128 * bj + 32 * wc + 16 * n + 4 * fq)

__device__ __forceinline__ float row_rstd(const float* __restrict__ ps, size_t row) {
  const float4* p4 = (const float4*)(ps + row * 16);
  float4 a = p4[0], b = p4[1], c = p4[2], d = p4[3];
  float sm = ((a.x + a.y) + (a.z + a.w)) + ((b.x + b.y) + (b.z + b.w)) + ((c.x + c.y) + (c.z + c.w)) + ((d.x + d.y) + (d.z + d.w));
  return rsqrtf(sm * (1.0f / DM) + 1e-6f);
}
#define EPI_LANE(ld, es) ((unsigned)(((64 * wr + fr) * (ld) + 32 * wc + 4 * fq) * (es)))
#define EPI_CONST(ld, es) ((unsigned)(((128 * ai + 16 * m) * (ld) + 128 * bj + 16 * n) * (es)))

#define RS_DECL(psptr, rowbase) float4 rq0 = make_float4(0.f, 0.f, 0.f, 0.f), rq1 = rq0, rq2 = rq0, rq3 = rq0; \
  if (psptr) { const float4* p4_ = (const float4*)((psptr) + ((rowbase) + 64 * wr + fr) * 16); rq0 = p4_[0]; rq1 = p4_[1]; rq2 = p4_[2]; rq3 = p4_[3]; }
#define RS_TAKE(psptr, rowbase) \
  const float rs = (psptr) ? rsqrtf((((rq0.x + rq0.y) + (rq0.z + rq0.w)) + ((rq1.x + rq1.y) + (rq1.z + rq1.w)) + ((rq2.x + rq2.y) + (rq2.z + rq2.w)) + ((rq3.x + rq3.y) + (rq3.z + rq3.w))) * (1.0f / DM) + 1e-6f) : 1.0f; \
  if ((psptr) && !(ai == 1 && m == 3)) { const int nr_ = (m == 3) ? 128 : (128 * ai + 16 * (m + 1)); \
    const float4* p4_ = (const float4*)((psptr) + ((rowbase) + nr_ + 64 * wr + fr) * 16); rq0 = p4_[0]; rq1 = p4_[1]; rq2 = p4_[2]; rq3 = p4_[3]; }

struct EpiAB {
  static constexpr bool AFTER_DRAIN = false;
  bf16_t* z1; bf16_t* z2; const float* ps;
  __device__ __forceinline__ void operator()(const f32x4 (&acc)[2][2][4][2], const Unit& u, int wr, int wc, int fr, int fq) const {
    EPI_FENCE;
    asm volatile("" : "+v"(fr), "+v"(fq));
    char* b1 = (char*)(z1 + (size_t)u.pm * 256 * RWKV_IN + u.pn * 256);
    char* b2 = (char*)(z2 + (size_t)u.pm * 256 * ATT_IN + u.pn * 256 - RWKV_IN);
    const unsigned l1 = EPI_LANE(RWKV_IN, 2), l2 = EPI_LANE(ATT_IN, 2);
    const int ncl = u.pn * 256 + 32 * wc + 4 * fq;
    RS_DECL(ps, (size_t)u.pm * 256)
    EPI_ROWS {
      RS_TAKE(ps, (size_t)u.pm * 256)
      EPI_COLS {
        const int nc = ncl + 128 * bj + 16 * n;
        const f32x4 v = acc[ai][bj][m][n] * rs;
        uint2 o; o.x = pack2(v[0], v[1]); o.y = pack2(v[2], v[3]);
        if (nc < RWKV_IN) *(uint2*)(b1 + (l1 + EPI_CONST(RWKV_IN, 2))) = o;
        else if (nc < AB_IN) *(uint2*)(b2 + (l2 + EPI_CONST(ATT_IN, 2))) = o;
      }
      EPI_FENCE;
    }
  }
};
__device__ __forceinline__ void ph_gemm_ab(int g_wv, const bf16_t* __restrict__ hb, const bf16_t* __restrict__ W, bf16_t* __restrict__ z1, bf16_t* __restrict__ z2, const float* ps, char* smem) {
  TileSched S{TG / 256, AB_PAD / 256, 4, DM, 256, 0, 0};
  gemm_phase(g_wv, (PG8_LAS unsigned char*)smem, Gemm{hb, W, DM, DM}, S, EpiAB{z1, z2, ps});
}

struct EpiLora {
  static constexpr bool AFTER_DRAIN = false;
  const float* w0; const float* a0; bf16_t* ea; bf16_t* gb;
  template <int MODE>
  __device__ __forceinline__ void run(const f32x4 (&acc)[2][2][4][2], const Unit& u, int wr, int wc, int fr, int fq) const {
    const int tn = u.pn;
    const int ncl = tn * 256 + 32 * wc + 4 * fq;
    const float* bp = (MODE == 0) ? (w0 + ncl) : (a0 + ncl - 1024);
    float4 bv[2][2];
    EPI_COLS { bv[bj][n] = (MODE < 2) ? *(const float4*)(bp + 128 * bj + 16 * n) : make_float4(0.f, 0.f, 0.f, 0.f); }
    char* bo = (MODE < 2) ? (char*)(ea + (size_t)u.pm * 256 * 2048 + tn * 256) : (char*)(gb + (size_t)u.pm * 256 * RW + tn * 256 - 2048);
    const unsigned lo = (MODE < 2) ? EPI_LANE(2048, 2) : EPI_LANE(RW, 2);
    EPI_ROWS {
      EPI_COLS {
        const f32x4 v = acc[ai][bj][m][n];
        const float4 b = bv[bj][n];
        float o0, o1, o2, o3;
        if (MODE == 0) {
          o0 = 0.60653066f * sigmoidf_(v[0] + b.x); o1 = 0.60653066f * sigmoidf_(v[1] + b.y);
          o2 = 0.60653066f * sigmoidf_(v[2] + b.z); o3 = 0.60653066f * sigmoidf_(v[3] + b.w);
        } else if (MODE == 1) {
          o0 = sigmoidf_(v[0] + b.x); o1 = sigmoidf_(v[1] + b.y); o2 = sigmoidf_(v[2] + b.z); o3 = sigmoidf_(v[3] + b.w);
        } else { o0 = v[0]; o1 = v[1]; o2 = v[2]; o3 = v[3]; }
        uint2 o; o.x = pack2(o0, o1); o.y = pack2(o2, o3);
        *(uint2*)(bo + (lo + ((MODE < 2) ? EPI_CONST(2048, 2) : EPI_CONST(RW, 2)))) = o;
        EPI_FENCE;
      }
    }
  }
  __device__ __forceinline__ void operator()(const f32x4 (&acc)[2][2][4][2], const Unit& u, int wr, int wc, int fr, int fq) const {
    EPI_FENCE;
    asm volatile("" : "+v"(fr), "+v"(fq));
    if (u.pn < 4) run<0>(acc, u, wr, wc, fr, fq);
    else if (u.pn < 8) run<1>(acc, u, wr, wc, fr, fq);
    else run<2>(acc, u, wr, wc, fr, fq);
  }
};
__device__ __forceinline__ void ph_gemm_lora(int g_wv, const bf16_t* __restrict__ L, const bf16_t* __restrict__ W, const float* __restrict__ w0, const float* __restrict__ a0,
                             bf16_t* __restrict__ ea, bf16_t* __restrict__ gb, char* smem) {
  TileSched S{TG / 256, NLORA / 256, 10, KLORA, 256, 0, 0, 8, 128};
  gemm_phase(g_wv, (PG8_LAS unsigned char*)smem, Gemm{L, W, KLORA, 256}, S, EpiLora{w0, a0, ea, gb});
}

struct EpiRes {
  static constexpr bool AFTER_DRAIN = false;
  const float* xsrc; float* xdst;
  const float* gn; bf16_t* xg; float* ps;
  __device__ __forceinline__ void operator()(const f32x4 (&acc)[2][2][4][2], const Unit& u, int wr, int wc, int fr, int fq) const {
    EPI_FENCE;
    asm volatile("" : "+v"(fr), "+v"(fq));
    const size_t tb = ((size_t)u.pm * 256 * DM + u.pn * 256) * 4;
    const char* bs = (const char*)xsrc + tb; char* bd = (char*)xdst + tb;
    char* bg2 = (char*)xg + tb / 2;
    const float* gp = gn + u.pn * 256 + 32 * wc + 4 * fq;
    const unsigned lo = EPI_LANE(DM, 4);
#pragma unroll
    for (int ai = 0; ai < 2; ++ai) {
      float4 xs[4][2][2];
#pragma unroll
      for (int m = 0; m < 4; ++m) { EPI_COLS { xs[m][bj][n] = *(const float4*)(bs + (lo + EPI_CONST(DM, 4))); } }
      EPI_FENCE;
#pragma unroll
      for (int m = 0; m < 4; ++m) {
        float ssq = 0.f;
        EPI_COLS {
          const f32x4 v = acc[ai][bj][m][n]; const float4 x4 = xs[m][bj][n];
          const float4 o = make_float4(x4.x + v[0], x4.y + v[1], x4.z + v[2], x4.w + v[3]);
          *(float4*)(bd + (lo + EPI_CONST(DM, 4))) = o;
          if (xg) {
            const float4 g4 = *(const float4*)(gp + 128 * bj + 16 * n);
            uint2 q; q.x = pack2(o.x * g4.x, o.y * g4.y); q.y = pack2(o.z * g4.z, o.w * g4.w);
            *(uint2*)(bg2 + (lo + EPI_CONST(DM, 4)) / 2) = q;
            ssq += (o.x * o.x + o.y * o.y) + (o.z * o.z + o.w * o.w);
          }
        }
        if (xg) {
          ssq += __shfl_xor(ssq, 16, 64);
          ssq += __shfl_xor(ssq, 32, 64);
          if (fq == 0) ps[((size_t)u.pm * 256 + EPI_ROW) * 16 + u.pn * 4 + wc] = ssq;
        }
        EPI_FENCE;
      }
    }
  }
};
__device__ __forceinline__ void ph_gemm_res(int g_wv, const bf16_t* __restrict__ A, int K, const bf16_t* __restrict__ W, const float* xsrc, float* xdst,
                                            const float* gn, bf16_t* xg, float* ps, char* smem) {
  TileSched S{TG / 256, DM / 256, 4, K, 256, 0, 0};
  gemm_phase(g_wv, (PG8_LAS unsigned char*)smem, Gemm{A, W, K, K}, S, EpiRes{xsrc, xdst, gn, xg, ps});
}

template <bool HAS_SCALE> struct EpiBf16 {
  static constexpr bool AFTER_DRAIN = false;
  const float* scale; bf16_t* out; const float* ps;
  __device__ __forceinline__ void operator()(const f32x4 (&acc)[2][2][4][2], const Unit& u, int wr, int wc, int fr, int fq) const {
    EPI_FENCE;
    asm volatile("" : "+v"(fr), "+v"(fq));
    const float* sp = scale + (HAS_SCALE ? (u.pn * 256 + 32 * wc + 4 * fq) : 0);
    char* bo = (char*)(out + (size_t)u.pm * 256 * DM + u.pn * 256);
    const unsigned lo = EPI_LANE(DM, 2);
    RS_DECL(ps, (size_t)u.pm * 256)
    EPI_ROWS {
      RS_TAKE(ps, (size_t)u.pm * 256)
      EPI_COLS {
        const f32x4 v = acc[ai][bj][m][n] * rs;
        uint2 o;
        if (HAS_SCALE) { const float4 s = *(const float4*)(sp + 128 * bj + 16 * n); o.x = pack2(v[0] * s.x, v[1] * s.y); o.y = pack2(v[2] * s.z, v[3] * s.w); } else { o.x = pack2(v[0], v[1]); o.y = pack2(v[2], v[3]); }
        *(uint2*)(bo + (lo + EPI_CONST(DM, 2))) = o;
        EPI_FENCE;
      }
    }
  }
};
__device__ __forceinline__ void ph_gemm_bf16(int g_wv, const bf16_t* __restrict__ A, int lda, int K, int grouped, const bf16_t* __restrict__ W, const float* __restrict__ scale,
                             bf16_t* __restrict__ out, const float* ps, char* smem) {
  TileSched S{TG / 256, DM / 256, 4, lda, 256, 0, grouped ? 256 : 0};
  if (scale) gemm_phase(g_wv, (PG8_LAS unsigned char*)smem, Gemm{A, W, lda, K}, S, EpiBf16<true>{scale, out, ps});
  else gemm_phase(g_wv, (PG8_LAS unsigned char*)smem, Gemm{A, W, lda, K}, S, EpiBf16<false>{scale, out, ps});
}

struct EpiFFN {
  static constexpr bool AFTER_DRAIN = true;
  const float* cw; const float* cb; bf16_t* act; int S; const float* ps; bf16_t* edge;
  __device__ __forceinline__ void operator()(const f32x4 (&)[2][2][4][2], const Unit&, int, int, int, int) const {}
  __device__ __forceinline__ void fused(f32x4 (&acc)[2][2][4][2], const Unit& u, int wr, int wc, int fr, int fq, PG8_LAS unsigned char* ldsp, int wid, int lane) const {
    char* U = (char*)ldsp;
    const int tid = wid * 64 + lane;
    const int s0 = u.pm * 256, tn = u.pn;
#pragma unroll
    for (int ai = 0; ai < 2; ++ai)
#pragma unroll
      for (int m = 0; m < 4; ++m) {
        const int row = EPI_ROW;
        const int grow = s0 + row;
        const float rs = (grow >= 0 && grow < TG) ? row_rstd(ps, (size_t)grow) : 0.f;
#pragma unroll
        for (int bj = 0; bj < 2; ++bj)
#pragma unroll
          for (int n = 0; n < 2; ++n) {
            const f32x4 v = acc[ai][bj][m][n] * rs;
            const int col = 128 * bj + 32 * wc + 16 * n + 4 * fq;
            uint2 o; o.x = pack2(v[0], v[1]); o.y = pack2(v[2], v[3]);
            *(uint2*)(U + row * 512 + (((col >> 3) ^ (row & 15)) << 4) + (col & 4) * 2) = o;
          }
      }
    __syncthreads();
    if (tid < 128) {
      const int er = tid >> 5, k = tid & 31;
      const int r = (er < 2) ? er : 252 + er;
      const uint4 v = *(const uint4*)(U + r * 512 + ((k ^ (r & 15)) << 4));
      const int ch = (k < 16) ? (tn * 128 + k * 8) : (DFF + tn * 128 + (k - 16) * 8);
      *(uint4*)(edge + ((size_t)u.pm * 4 + er) * UP + ch) = v;
    }
    {
      const int kq = tid & 15, rg = tid >> 4;
      const int cg_ = tn * 128 + kq * 8;
      float g0[8], g1[8], g2[8], gb[8], v0[8], v1[8], v2[8], vb[8];
#define LD8F(dst, ptr) { const float4 t0_ = *(const float4*)(ptr), t1_ = *(const float4*)((ptr) + 4); dst[0] = t0_.x; dst[1] = t0_.y; dst[2] = t0_.z; dst[3] = t0_.w; dst[4] = t1_.x; dst[5] = t1_.y; dst[6] = t1_.z; dst[7] = t1_.w; }
      LD8F(g0, cw + cg_) LD8F(g1, cw + UP + cg_) LD8F(g2, cw + 2 * UP + cg_) LD8F(gb, cb + cg_)
      LD8F(v0, cw + DFF + cg_) LD8F(v1, cw + UP + DFF + cg_) LD8F(v2, cw + 2 * UP + DFF + cg_) LD8F(vb, cb + DFF + cg_)
#undef LD8F
#pragma unroll 2
      for (int i = 0; i < 8; ++i) {
        const int r = 1 + rg + 32 * i;
        const int sq = s0 + r;
        if (r <= 254 && sq < TG) {
          const int sp = sq & (S - 1);
          const float mp = (sp == 0) ? 0.f : 1.f, mn = (sp == S - 1) ? 0.f : 1.f;
          float a0[8], a1[8], a2[8], b0[8], b1[8], b2[8];
          unpack8(*(const uint4*)(U + (r - 1) * 512 + ((kq ^ ((r - 1) & 15)) << 4)), a0);
          unpack8(*(const uint4*)(U + r * 512 + ((kq ^ (r & 15)) << 4)), a1);
          unpack8(*(const uint4*)(U + (r + 1) * 512 + ((kq ^ ((r + 1) & 15)) << 4)), a2);
          unpack8(*(const uint4*)(U + (r - 1) * 512 + (((16 + kq) ^ ((r - 1) & 15)) << 4)), b0);
          unpack8(*(const uint4*)(U + r * 512 + (((16 + kq) ^ (r & 15)) << 4)), b1);
          unpack8(*(const uint4*)(U + (r + 1) * 512 + (((16 + kq) ^ ((r + 1) & 15)) << 4)), b2);
          float o[8];
#pragma unroll
          for (int q = 0; q < 8; ++q) {
            const float gx = a0[q] * mp * g0[q] + a1[q] * g1[q] + a2[q] * mn * g2[q] + gb[q];
            const float vx = b0[q] * mp * v0[q] + b1[q] * v1[q] + b2[q] * mn * v2[q] + vb[q];
            o[q] = gelu_tanh(gx) * vx;
          }
          *(uint4*)(act + (size_t)sq * DFF + cg_) = make_uint4(pack2(o[0], o[1]), pack2(o[2], o[3]), pack2(o[4], o[5]), pack2(o[6], o[7]));
        }
      }
    }
  }
};
__device__ __forceinline__ void ph_ffn_edges(int g_wv, const bf16_t* __restrict__ edge, const float* __restrict__ cw, const float* __restrict__ cb, bf16_t* __restrict__ act, int S) {
  const int total = (TG / 256) * 2 * (DFF / 8);
  for (int e = blockIdx.x * NT + tid_opaque(); e < total; e += gridDim.x * NT) {
    const int ck = e % (DFF / 8), rr = e / (DFF / 8);
    const int pm = rr >> 1, which = rr & 1;
    const int c = ck * 8;
    const int t = pm * 256 + (which ? 255 : 0);
    const int sp = t & (S - 1);
    const float mp = (sp == 0) ? 0.f : 1.f, mn = (sp == S - 1) ? 0.f : 1.f;
    const int pmA = which ? pm : ((pm > 0) ? pm - 1 : pm), slA = which ? 2 : 3;
    const int pmC = which ? ((pm < TG / 256 - 1) ? pm + 1 : pm) : pm, slC = which ? 0 : 1;
    const int slB = which ? 3 : 0;
    float a0[8], a1[8], a2[8], b0[8], b1[8], b2[8];
    unpack8(*(const uint4*)(edge + ((size_t)pmA * 4 + slA) * UP + c), a0);
    unpack8(*(const uint4*)(edge + ((size_t)pm * 4 + slB) * UP + c), a1);
    unpack8(*(const uint4*)(edge + ((size_t)pmC * 4 + slC) * UP + c), a2);
    unpack8(*(const uint4*)(edge + ((size_t)pmA * 4 + slA) * UP + DFF + c), b0);
    unpack8(*(const uint4*)(edge + ((size_t)pm * 4 + slB) * UP + DFF + c), b1);
    unpack8(*(const uint4*)(edge + ((size_t)pmC * 4 + slC) * UP + DFF + c), b2);
    float o[8];
#pragma unroll
    for (int q = 0; q < 8; ++q) {
      const float gx = a0[q] * mp * cw[c + q] + a1[q] * cw[UP + c + q] + a2[q] * mn * cw[2 * UP + c + q] + cb[c + q];
      const float vx = b0[q] * mp * cw[DFF + c + q] + b1[q] * cw[UP + DFF + c + q] + b2[q] * mn * cw[2 * UP + DFF + c + q] + cb[DFF + c + q];
      o[q] = gelu_tanh(gx) * vx;
    }
    *(uint4*)(act + (size_t)t * DFF + c) = make_uint4(pack2(o[0], o[1]), pack2(o[2], o[3]), pack2(o[4], o[5]), pack2(o[6], o[7]));
  }
}

__device__ __forceinline__ void ph_ffn_up(int g_wv, const bf16_t* __restrict__ hb, const bf16_t* __restrict__ W, const float* __restrict__ cw, const float* __restrict__ cb,
                          bf16_t* __restrict__ act, int B, int S, const float* ps, const float* __restrict__ p, bf16_t* __restrict__ pb, bf16_t* edge, char* smem) {
  for (int e = blockIdx.x * NT + tid_opaque(); e < TG * PLE / 8; e += gridDim.x * NT) {
    float4 a = *(const float4*)(p + (size_t)e * 8), b = *(const float4*)(p + (size_t)e * 8 + 4);
    *(uint4*)(pb + (size_t)e * 8) = make_uint4(pack2(a.x, a.y), pack2(a.z, a.w), pack2(b.x, b.y), pack2(b.z, b.w));
  }
  const int nts = TG / 256;
  TileSched TS{nts, UP / 256, 4, DM, 256, 0, 0};
  const int ntiles = nts * (UP / 256);
  for (int t0 = blockIdx.x; t0 < ntiles; t0 += gridDim.x) {
    OneUnit O; TS.fill(t0, O.u);
    __syncthreads();
    gemm_phase(g_wv, (PG8_LAS unsigned char*)smem, Gemm{hb, W, DM, DM}, O, EpiFFN{cw, cb, act, S, ps, edge});
  }
}

struct EpiPle {
  static constexpr bool AFTER_DRAIN = false;
  const float* bg; const bf16_t* prj; float* x; const float* psin;
  const float* gn; bf16_t* xg; float* ps;
  __device__ __forceinline__ void operator()(const f32x4 (&acc)[2][2][4][2], const Unit& u, int wr, int wc, int fr, int fq) const {
    EPI_FENCE;
    asm volatile("" : "+v"(fr), "+v"(fq));
    const float* bp2 = bg + u.pn * 256 + 32 * wc + 4 * fq;
    const float* gp = gn + u.pn * 256 + 32 * wc + 4 * fq;
    const size_t te = (size_t)u.pm * 256 * DM + u.pn * 256;
    char* bx = (char*)(x + te); const char* bp = (const char*)(prj + te); char* bg2 = (char*)(xg + te);
    const unsigned lx = EPI_LANE(DM, 4), lp = EPI_LANE(DM, 2);
    EPI_ROWS {
      float4 xs4[2][2], b4[2][2]; uint2 pq4[2][2];
      const float4* rp4 = (const float4*)(psin + ((size_t)u.pm * 256 + EPI_ROW) * 16);
      const float4 ra = rp4[0], rb = rp4[1], rc = rp4[2], rd = rp4[3];
      float4 g44[2][2];
      EPI_COLS {
        b4[bj][n] = *(const float4*)(bp2 + 128 * bj + 16 * n);
        g44[bj][n] = xg ? *(const float4*)(gp + 128 * bj + 16 * n) : make_float4(0.f, 0.f, 0.f, 0.f);
        pq4[bj][n] = *(const uint2*)(bp + (lp + EPI_CONST(DM, 2)));
        xs4[bj][n] = *(const float4*)(bx + (lx + EPI_CONST(DM, 4)));
      }
      EPI_FENCE;
      const float rs = rsqrtf((((ra.x + ra.y) + (ra.z + ra.w)) + ((rb.x + rb.y) + (rb.z + rb.w)) + ((rc.x + rc.y) + (rc.z + rc.w)) + ((rd.x + rd.y) + (rd.z + rd.w))) * (1.0f / DM) + 1e-6f);
      float ssq = 0.f;
      EPI_COLS {
        const f32x4 v = acc[ai][bj][m][n] * rs;
        const float4 b = b4[bj][n]; const uint2 pq = pq4[bj][n]; float4 xs = xs4[bj][n];
        xs.x += sigmoidf_(v[0] + b.x) * lo2f(pq.x); xs.y += sigmoidf_(v[1] + b.y) * hi2f(pq.x);
        xs.z += sigmoidf_(v[2] + b.z) * lo2f(pq.y); xs.w += sigmoidf_(v[3] + b.w) * hi2f(pq.y);
        *(float4*)(bx + (lx + EPI_CONST(DM, 4))) = xs;
        if (xg) {
          const float4 g4 = g44[bj][n];
          uint2 q; q.x = pack2(xs.x * g4.x, xs.y * g4.y); q.y = pack2(xs.z * g4.z, xs.w * g4.w);
          *(uint2*)(bg2 + (lp + EPI_CONST(DM, 2))) = q;
          ssq += (xs.x * xs.x + xs.y * xs.y) + (xs.z * xs.z + xs.w * xs.w);
        }
      }
      if (xg) {
        ssq += __shfl_xor(ssq, 16, 64);
        ssq += __shfl_xor(ssq, 32, 64);
        if (fq == 0) ps[((size_t)u.pm * 256 + EPI_ROW) * 16 + u.pn * 4 + wc] = ssq;
      }
      EPI_FENCE;
    }
  }
};
__device__ __forceinline__ void ph_ple(int g_wv, const bf16_t* __restrict__ hb, const bf16_t* __restrict__ Wg, const float* __restrict__ bg, const bf16_t* __restrict__ pb,
                       const bf16_t* __restrict__ Wp, bf16_t* prj, float* x, const float* psin, const float* gn, bf16_t* xg, float* ps, char* smem) {
  TileSched S1{TG / 256, DM / 256, 4, PLE, 256, 0, 0};
  gemm_phase(g_wv, (PG8_LAS unsigned char*)smem, Gemm{pb, Wp, PLE, PLE}, S1, EpiBf16<false>{nullptr, prj, nullptr});
  __syncthreads();
  TileSched S2{TG / 256, DM / 256, 4, DM, 256, 0, 0};
  gemm_phase(g_wv, (PG8_LAS unsigned char*)smem, Gemm{hb, Wg, DM, DM}, S2, EpiPle{bg, prj, x, psin, gn, xg, ps});
}

__device__ __forceinline__ void ph_attention(int g_wv, const bf16_t* __restrict__ z2, const float2* __restrict__ rot, float* __restrict__ opart, float* __restrict__ lsep,
                             int B, int S, char* smem) {
  const int tidf = tid_opaque(), half = tidf >> 8;
  const int tid = tidf & 255, lane = tid & 63, w4 = tid >> 6, quad = lane >> 4, l15 = lane & 15;
  bf16_t* sK = (bf16_t*)(smem + half * 53248);
  bf16_t* sVt = (bf16_t*)(smem + half * 53248 + 192 * 72 * 2);
  const int tps = S / 64;
  const int per_g = B * 4 * tps;
  const int nunits = 3 * per_g;
  for (int u = blockIdx.x * 2 + half; u < nunits; u += gridDim.x * 2) {
    const int ltps = 31 - __clz(tps), lpg = 31 - __clz(per_g);
    int g = u >> lpg, rem = u & (per_g - 1);
    int b = rem >> (ltps + 2), rem2 = rem & (4 * tps - 1);
    int hg = rem2 >> ltps, w = rem2 & (tps - 1);
    int dil = (g == 0) ? 1 : (g == 1 ? 4 : 16);
    const int ldil = (g == 0) ? 0 : (g == 1 ? 2 : 4);
    int Ls = S >> ldil;
    int lt = w >> ldil, rho = w & (dil - 1);
    int l0 = lt * 64;
    int head = g * 4 + hg;
    const bf16_t* zb = z2 + (size_t)b * S * ATT_IN;
    __syncthreads();
#pragma unroll
    for (int it = 0; it < 3; ++it) {
      int e = tid + 256 * it;
      int jj = e >> 2, part = e & 3;
      int lk = l0 - 64 + jj;
      bool valid = (lk >= 0) && (lk < Ls);
      int s = lk * dil + rho;
      uint4 k0 = make_uint4(0, 0, 0, 0), k1 = k0, v0 = k0, v1 = k0;
      if (valid) {
        const bf16_t* kr = zb + (size_t)s * ATT_IN + 768 + head * 64 + part * 16;
        const bf16_t* vr = zb + (size_t)s * ATT_IN + 1536 + head * 64 + part * 16;
        k0 = *(const uint4*)kr; k1 = *(const uint4*)(kr + 8);
        v0 = *(const uint4*)vr; v1 = *(const uint4*)(vr + 8);
        if (part == 0) {
          const float2* rt = rot + (size_t)s * 8;
          unsigned x1[4] = {k0.x, k0.y, k0.z, k0.w}, x2[4] = {k1.x, k1.y, k1.z, k1.w};
#pragma unroll
          for (int q = 0; q < 4; ++q) {
            float2 c0 = rt[2 * q], c1 = rt[2 * q + 1];
            float a0 = lo2f(x1[q]), a1 = hi2f(x1[q]), b0 = lo2f(x2[q]), b1 = hi2f(x2[q]);
            x1[q] = pack2(a0 * c0.x - b0 * c0.y, a1 * c1.x - b1 * c1.y);
            x2[q] = pack2(b0 * c0.x + a0 * c0.y, b1 * c1.x + a1 * c1.y);
          }
          k0 = make_uint4(x1[0], x1[1], x1[2], x1[3]); k1 = make_uint4(x2[0], x2[1], x2[2], x2[3]);
        }
      }
      *(uint4*)(sK + jj * 72 + part * 16) = k0;
      *(uint4*)(sK + jj * 72 + part * 16 + 8) = k1;
      unsigned vv[8] = {v0.x, v0.y, v0.z, v0.w, v1.x, v1.y, v1.z, v1.w};
#pragma unroll
      for (int q = 0; q < 8; ++q) {
        sVt[(part * 16 + 2 * q) * 200 + jj] = (bf16_t)(vv[q] & 0xffffu);
        sVt[(part * 16 + 2 * q + 1) * 200 + jj] = (bf16_t)(vv[q] >> 16);
      }
    }
    const int qi = w4 * 16 + l15;
    const int sq = (l0 + qi) * dil + rho;
    bf16x8 qf[2];
    {
      const bf16_t* qr = zb + (size_t)sq * ATT_IN + head * 64;
      uint4 c[2];
      c[0] = *(const uint4*)(qr + quad * 8);
      c[1] = *(const uint4*)(qr + 32 + quad * 8);
      unsigned xs[4] = {c[0].x, c[0].y, c[0].z, c[0].w};
      if (quad < 2) {
        uint4 oth = *(const uint4*)(qr + (quad ^ 1) * 8);
        unsigned xo[4] = {oth.x, oth.y, oth.z, oth.w};
        const float2* rt = rot + (size_t)sq * 8;
#pragma unroll
        for (int q = 0; q < 4; ++q) {
          float2 c0 = rt[2 * q], c1 = rt[2 * q + 1];
          float a0 = lo2f(xs[q]), a1 = hi2f(xs[q]), b0 = lo2f(xo[q]), b1 = hi2f(xo[q]);
          float r0 = (quad == 0) ? (a0 * c0.x - b0 * c0.y) : (a0 * c0.x + b0 * c0.y);
          float r1 = (quad == 0) ? (a1 * c1.x - b1 * c1.y) : (a1 * c1.x + b1 * c1.y);
          xs[q] = pack2(r0, r1);
        }
      }
      unsigned all[8] = {xs[0], xs[1], xs[2], xs[3], c[1].x, c[1].y, c[1].z, c[1].w};
#pragma unroll
      for (int q = 0; q < 8; ++q) all[q] = pack2(lo2f(all[q]) * 0.125f, hi2f(all[q]) * 0.125f);
      uint4 t0 = make_uint4(all[0], all[1], all[2], all[3]), t1 = make_uint4(all[4], all[5], all[6], all[7]);
      qf[0] = *(bf16x8*)&t0; qf[1] = *(bf16x8*)&t1;
    }
    __syncthreads();
    const int kt0 = (w4 < 2) ? w4 : 2;
    f32x4 sc[10];
#pragma unroll
    for (int kt = 0; kt < 10; ++kt) {
      f32x4 a = (f32x4){0.f, 0.f, 0.f, 0.f};
#pragma unroll
      for (int ks = 0; ks < 2; ++ks) {
        bf16x8 kf = *(const bf16x8*)(sK + ((kt0 + kt) * 16 + l15) * 72 + ks * 32 + quad * 8);
        a = __builtin_amdgcn_mfma_f32_16x16x32_bf16(kf, qf[ks], a, 0, 0, 0);
      }
      sc[kt] = a;
    }
    float mx = -1e30f;
#pragma unroll
    for (int kt = 0; kt < 10; ++kt)
#pragma unroll
      for (int r = 0; r < 4; ++r) {
        int jj = (kt0 + kt) * 16 + quad * 4 + r;
        int lk = l0 - 64 + jj;
        bool valid = (jj >= qi) && (jj <= qi + 128) && (lk >= 0) && (lk < Ls);
        float sv = valid ? sc[kt][r] : -1e30f;
        sc[kt][r] = sv;
        mx = fmaxf(mx, sv);
      }
    mx = fmaxf(mx, __shfl_xor(mx, 16, 64));
    mx = fmaxf(mx, __shfl_xor(mx, 32, 64));
    float den = 0.f;
#pragma unroll
    for (int kt = 0; kt < 10; ++kt)
#pragma unroll
      for (int r = 0; r < 4; ++r) { float p = __expf(sc[kt][r] - mx); sc[kt][r] = p; den += p; }
    den += __shfl_xor(den, 16, 64);
    den += __shfl_xor(den, 32, 64);
    f32x4 oacc[4];
#pragma unroll
    for (int dt = 0; dt < 4; ++dt) oacc[dt] = (f32x4){0.f, 0.f, 0.f, 0.f};
#pragma unroll
    for (int pp = 0; pp < 5; ++pp) {
      uint4 pk = make_uint4(pack2(sc[2 * pp][0], sc[2 * pp][1]), pack2(sc[2 * pp][2], sc[2 * pp][3]),
                            pack2(sc[2 * pp + 1][0], sc[2 * pp + 1][1]), pack2(sc[2 * pp + 1][2], sc[2 * pp + 1][3]));
      bf16x8 pf = *(bf16x8*)&pk;
#pragma unroll
      for (int dt = 0; dt < 4; ++dt) {
        const bf16_t* vp = sVt + (dt * 16 + l15) * 200 + (kt0 + 2 * pp) * 16 + quad * 4;
        uint2 va = *(const uint2*)vp, vb = *(const uint2*)(vp + 16);
        uint4 vk = make_uint4(va.x, va.y, vb.x, vb.y);
        bf16x8 vf = *(bf16x8*)&vk;
        oacc[dt] = __builtin_amdgcn_mfma_f32_16x16x32_bf16(vf, pf, oacc[dt], 0, 0, 0);
      }
    }
    float inv = 1.0f / den;
    float* op = opart + ((size_t)g * TG + (size_t)b * S + sq) * 256 + hg * 64;
#pragma unroll
    for (int dt = 0; dt < 4; ++dt)
      *(float4*)(op + dt * 16 + quad * 4) = make_float4(oacc[dt][0] * inv, oacc[dt][1] * inv, oacc[dt][2] * inv, oacc[dt][3] * inv);
    if (quad == 0) lsep[((size_t)g * TG + (size_t)b * S + sq) * 4 + hg] = mx + __logf(den);
  }
}

__device__ __forceinline__ void ph_attn_combine(int g_wv, const float* __restrict__ opart, const float* __restrict__ lsep, bf16_t* __restrict__ yab) {
  const int total = TG * 64;
  for (int e = blockIdx.x * NT + tid_opaque(); e < total; e += gridDim.x * NT) {
    int t = e >> 6, c = (e & 63) * 4, hg = c >> 6;
    float l0 = lsep[(size_t)t * 4 + hg], l1 = lsep[((size_t)TG + t) * 4 + hg], l2 = lsep[((size_t)2 * TG + t) * 4 + hg];
    float m = fmaxf(l0, fmaxf(l1, l2));
    float w0 = __expf(l0 - m), w1 = __expf(l1 - m), w2 = __expf(l2 - m);
    float inv = 1.0f / (w0 + w1 + w2);
    w0 *= inv; w1 *= inv; w2 *= inv;
    float4 a = *(const float4*)(opart + (size_t)t * 256 + c);
    float4 b = *(const float4*)(opart + ((size_t)TG + t) * 256 + c);
    float4 d = *(const float4*)(opart + ((size_t)2 * TG + t) * 256 + c);
    uint2 o;
    o.x = pack2(w0 * a.x + w1 * b.x + w2 * d.x, w0 * a.y + w1 * b.y + w2 * d.y);
    o.y = pack2(w0 * a.z + w1 * b.z + w2 * d.z, w0 * a.w + w1 * b.w + w2 * d.w);
    *(uint2*)(yab + (size_t)t * AB_OUT + 512 + c) = o;
  }
}

__device__ __forceinline__ void ph_rwkv_prep(int g_wv, const bf16_t* __restrict__ z1, const float* __restrict__ mu, bf16_t* __restrict__ rkv, bf16_t* __restrict__ L, int S,
                                             const float* __restrict__ k_k, float* __restrict__ knorm) {
  const int total = TG * 240;
  for (int e = blockIdx.x * NT + tid_opaque(); e < total; e += gridDim.x * NT) {
    const int t = e / 240, c = (e - t * 240) * 8;
    const int s = t & (S - 1);
    const bf16_t* zc = z1 + (size_t)t * RWKV_IN + c;
    const uint4 uc = *(const uint4*)zc;
    uint4 um = make_uint4(0, 0, 0, 0), up = make_uint4(0, 0, 0, 0);
    if (s > 0) um = *(const uint4*)(zc - RWKV_IN);
    if (s < S - 1) up = *(const uint4*)(zc + RWKV_IN);
    const float4 m0 = *(const float4*)(mu + c), m1 = *(const float4*)(mu + c + 4);
    const unsigned ucs[4] = {uc.x, uc.y, uc.z, uc.w}, ums[4] = {um.x, um.y, um.z, um.w}, ups[4] = {up.x, up.y, up.z, up.w};
    const float mus[8] = {m0.x, m0.y, m0.z, m0.w, m1.x, m1.y, m1.z, m1.w};
    unsigned o[4];
#pragma unroll
    for (int q = 0; q < 4; ++q) {
      float z0 = lo2f(ucs[q]), z1v = hi2f(ucs[q]);
      float r0 = z0 + mus[2 * q] * (0.5f * (lo2f(ums[q]) + lo2f(ups[q])) - z0);
      float r1 = z1v + mus[2 * q + 1] * (0.5f * (hi2f(ums[q]) + hi2f(ups[q])) - z1v);
      if (c >= 1536 && c < 1664) { r0 = tanhf_(r0); r1 = tanhf_(r1); }
      else if (c >= 1792) { r0 = sigmoidf_(r0); r1 = sigmoidf_(r1); }
      o[q] = pack2(r0, r1);
    }
    if (c < 1536) *(uint4*)(rkv + (size_t)t * 1536 + c) = make_uint4(o[0], o[1], o[2], o[3]);
    else *(uint4*)(L + (size_t)t * KLORA + c - 1536) = make_uint4(o[0], o[1], o[2], o[3]);
    const bool isk = (c >= 512 && c < 1024);
    float ss = 0.f;
    if (isk) {
      const float4 q0 = *(const float4*)(k_k + c - 512), q1 = *(const float4*)(k_k + c - 512 + 4);
      const float kq[8] = {q0.x, q0.y, q0.z, q0.w, q1.x, q1.y, q1.z, q1.w};
#pragma unroll
      for (int q = 0; q < 4; ++q) { float p0 = lo2f(o[q]) * kq[2 * q], p1 = hi2f(o[q]) * kq[2 * q + 1]; ss += p0 * p0 + p1 * p1; }
    }
    ss += __shfl_xor(ss, 1, 64); ss += __shfl_xor(ss, 2, 64); ss += __shfl_xor(ss, 4, 64);
    if (isk && ((c & 63) == 0)) knorm[(size_t)t * 8 + ((c - 512) >> 6)] = rsqrtf(ss + 1e-12f);
  }
}

struct ScanRaw { unsigned short r[TB], k[TB], v[TB], e[TB], a[TB]; float kn[TB]; };
__device__ __forceinline__ void scan_load(ScanRaw& raw, const bf16_t* __restrict__ rkv, const bf16_t* __restrict__ ea, const float* __restrict__ knorm,
                                          int b, int S, int h, int d, int tau0, int lane) {
  unsigned zl = 0; asm volatile("" : "+v"(zl));
#pragma unroll
  for (int i = 0; i < TB; ++i) {
    int tau = tau0 + i;
    int tt = (d == 0) ? tau : (S - 1 - tau);
    size_t row = (size_t)b * S + tt;
    raw.r[i] = rkv[row * 1536 + h * 64 + lane];
    raw.k[i] = rkv[row * 1536 + 512 + h * 64 + lane];
    raw.v[i] = rkv[row * 1536 + 1024 + h * 64 + lane];
    raw.e[i] = ea[row * 2048 + d * 512 + h * 64 + lane];
    raw.a[i] = ea[row * 2048 + 1024 + d * 512 + h * 64 + lane];
    raw.kn[i] = knorm[row * 8 + h + zl];
  }
}
__device__ __forceinline__ void scan_stage(float* st, const ScanRaw& raw, float kkp, float kap, int lane) {
#pragma unroll
  for (int i = 0; i < TB; ++i) {
    float rv = bf2f(raw.r[i]), kv = bf2f(raw.k[i]), vv = bf2f(raw.v[i]), e = bf2f(raw.e[i]), a = bf2f(raw.a[i]);
    float kk = kv * kkp * raw.kn[i];
    float* s = st + i * 384;
    s[lane] = kk;
    s[64 + lane] = __expf(-e);
    s[128 + lane] = kk * a;
    s[192 + lane] = kv * (1.0f + (a - 1.0f) * kap);
    s[256 + lane] = rv;
    s[320 + lane] = vv;
  }
}

#define SB_ __builtin_amdgcn_sched_barrier(0)
typedef float v2f __attribute__((ext_vector_type(2)));
__device__ __forceinline__ v2f lo2(const float4& a) { return (v2f){a.x, a.y}; }
__device__ __forceinline__ v2f hi2(const float4& a) { return (v2f){a.z, a.w}; }
template <bool EMIT_Y>
__device__ __forceinline__ void scan_block(v2f (&S2)[32], const float* st, float vsel, int lane, bf16_t* __restrict__ yout, long ystride) {
  float4 bA[8], bB[8];
#pragma unroll
  for (int z = 0; z < 8; ++z) bA[z] = *(const float4*)(st + 4 * z);
  for (int i = 0; i < TB; ++i) {
    const float* s = st + i * 384;
    const float vv = s[320 + lane] * vsel;
#pragma unroll
    for (int z = 0; z < 8; ++z) bB[z] = *(const float4*)(s + 32 + 4 * z);
    SB_;
    v2f accA = (v2f){0.f, 0.f}, accB = (v2f){0.f, 0.f};
#pragma unroll
    for (int z = 0; z < 8; ++z) { accA += S2[2 * z] * lo2(bA[z]); accB += S2[2 * z + 1] * hi2(bA[z]); }
    SB_;
#pragma unroll
    for (int z = 0; z < 2; ++z) { bA[z] = *(const float4*)(s + 64 + 4 * z); bA[2 + z] = *(const float4*)(s + 128 + 4 * z); bA[4 + z] = *(const float4*)(s + 192 + 4 * z); if (EMIT_Y) bA[6 + z] = *(const float4*)(s + 256 + 4 * z); }
    SB_;
#pragma unroll
    for (int z = 0; z < 8; ++z) { accA += S2[16 + 2 * z] * lo2(bB[z]); accB += S2[16 + 2 * z + 1] * hi2(bB[z]); }
    accA += accB;
    const float sa = accA.x + accA.y;
    const v2f nsa2 = (v2f){-sa, -sa}, vv2 = (v2f){vv, vv};
    v2f yA = (v2f){0.f, 0.f}, yB = (v2f){0.f, 0.f};
    SB_;
#pragma unroll
    for (int g = 0; g < 8; ++g) {
      float4(&cur)[8] = (g & 1) ? bB : bA;
      float4(&nxt)[8] = (g & 1) ? bA : bB;
      if (g < 7) {
#pragma unroll
        for (int z = 0; z < 2; ++z) {
          nxt[z] = *(const float4*)(s + 64 + 8 * (g + 1) + 4 * z); nxt[2 + z] = *(const float4*)(s + 128 + 8 * (g + 1) + 4 * z);
          nxt[4 + z] = *(const float4*)(s + 192 + 8 * (g + 1) + 4 * z); if (EMIT_Y) nxt[6 + z] = *(const float4*)(s + 256 + 8 * (g + 1) + 4 * z);
        }
      } else {
#pragma unroll
        for (int z = 0; z < 8; ++z) nxt[z] = *(const float4*)(s + 384 + 4 * z);
      }
      SB_;
#pragma unroll
      for (int z = 0; z < 2; ++z) {
        const int j = 4 * g + 2 * z;
        const float4 w4 = cur[z], a4 = cur[2 + z], d4 = cur[4 + z];
        S2[j] = S2[j] * lo2(w4) + nsa2 * lo2(a4) + vv2 * lo2(d4);
        S2[j + 1] = S2[j + 1] * hi2(w4) + nsa2 * hi2(a4) + vv2 * hi2(d4);
        if (EMIT_Y) { const float4 r4 = cur[6 + z]; yA += S2[j] * lo2(r4); yB += S2[j + 1] * hi2(r4); }
      }
      SB_;
    }
    if (EMIT_Y) { yA += yB; yout[(long)i * ystride] = f2bf(yA.x + yA.y); }
  }
}

__device__ __forceinline__ void scan_block_qm(v2f (&SQ)[32], v2f (&SM)[32], const float* st, int lane) {
  float4 bX[6], bY[6];
#pragma unroll
  for (int z = 0; z < 4; ++z) bX[z] = *(const float4*)(st + 4 * z);
  for (int i = 0; i < TB; ++i) {
    const float* s = st + i * 384;
    const float vv = s[320 + lane];
    v2f aQ0 = (v2f){0.f, 0.f}, aQ1 = (v2f){0.f, 0.f}, aM0 = (v2f){0.f, 0.f}, aM1 = (v2f){0.f, 0.f};
#pragma unroll
    for (int g = 0; g < 4; ++g) {
      float4(&cur)[6] = (g & 1) ? bY : bX;
      float4(&nxt)[6] = (g & 1) ? bX : bY;
      if (g < 3) {
#pragma unroll
        for (int z = 0; z < 4; ++z) nxt[z] = *(const float4*)(s + 16 * (g + 1) + 4 * z);
      } else {
#pragma unroll
        for (int z = 0; z < 2; ++z) { nxt[z] = *(const float4*)(s + 64 + 4 * z); nxt[2 + z] = *(const float4*)(s + 128 + 4 * z); nxt[4 + z] = *(const float4*)(s + 192 + 4 * z); }
      }
      SB_;
#pragma unroll
      for (int z = 0; z < 4; ++z) {
        const int j = 8 * g + 2 * z;
        aQ0 += SQ[j] * lo2(cur[z]); aQ1 += SQ[j + 1] * hi2(cur[z]);
        aM0 += SM[j] * lo2(cur[z]); aM1 += SM[j + 1] * hi2(cur[z]);
      }
      SB_;
    }
    aQ0 += aQ1; aM0 += aM1;
    const float saq = aQ0.x + aQ0.y, sam = aM0.x + aM0.y;
    const v2f nq2 = (v2f){-saq, -saq}, nm2 = (v2f){-sam, -sam}, vv2 = (v2f){vv, vv};
#pragma unroll
    for (int g = 0; g < 8; ++g) {
      float4(&cur)[6] = (g & 1) ? bY : bX;
      float4(&nxt)[6] = (g & 1) ? bX : bY;
      if (g < 7) {
#pragma unroll
        for (int z = 0; z < 2; ++z) { nxt[z] = *(const float4*)(s + 64 + 8 * (g + 1) + 4 * z); nxt[2 + z] = *(const float4*)(s + 128 + 8 * (g + 1) + 4 * z); nxt[4 + z] = *(const float4*)(s + 192 + 8 * (g + 1) + 4 * z); }
      } else {
#pragma unroll
        for (int z = 0; z < 4; ++z) nxt[z] = *(const float4*)(s + 384 + 4 * z);
      }
      SB_;
#pragma unroll
      for (int z = 0; z < 2; ++z) {
        const int j = 4 * g + 2 * z;
        const float4 w4 = cur[z], a4 = cur[2 + z], d4 = cur[4 + z];
        SQ[j] = SQ[j] * lo2(w4) + nq2 * lo2(a4) + vv2 * lo2(d4);
        SQ[j + 1] = SQ[j + 1] * hi2(w4) + nq2 * hi2(a4) + vv2 * hi2(d4);
        SM[j] = SM[j] * lo2(w4) + nm2 * lo2(a4);
        SM[j + 1] = SM[j + 1] * hi2(w4) + nm2 * hi2(a4);
      }
      SB_;
    }
  }
}

__device__ __forceinline__ void ph_scan_pass1(int g_wv, const bf16_t* __restrict__ rkv, const bf16_t* __restrict__ ea, const float* __restrict__ knorm, const float* __restrict__ k_k, const float* __restrict__ k_a,
                              float* __restrict__ Qb, float* __restrict__ Mb, int B, int S, char* smem) {
  const int NC = S / CHUNK_L;
  if (NC <= 1) return;
  const int lane = tid_opaque() & 63, wv = __builtin_amdgcn_readfirstlane(tid_opaque() >> 6);
  float* st = (float*)smem + wv * ((TB + 1) * 384);
  const int nunits = B * 8 * 2 * (NC - 1);
  for (int u = wv * gridDim.x + blockIdx.x; u < nunits; u += NW * gridDim.x) {
    const int nbhd = B * 16;
    int bhd = u & (nbhd - 1), ci = u >> (31 - __clz(nbhd));
    int d = bhd & 1, h = (bhd >> 1) & 7, b = bhd >> 4;
    float kkp = k_k[h * 64 + lane], kap = k_a[h * 64 + lane];
    v2f SQ[32], SM[32];
    int lane_i = lane;
    asm volatile("" : "+v"(lane_i));
#pragma unroll
    for (int k = 0; k < 32; ++k) { SQ[k] = (v2f){0.f, 0.f}; SM[k] = (v2f){(2 * k == lane_i) ? 1.f : 0.f, (2 * k + 1 == lane_i) ? 1.f : 0.f}; }
    ScanRaw raw;
    scan_load(raw, rkv, ea, knorm, b, S, h, d, ci * CHUNK_L, lane);
    for (int tb = 0; tb < CHUNK_L / TB; ++tb) {
      scan_stage(st, raw, kkp, kap, lane);
      if (tb + 1 < CHUNK_L / TB) scan_load(raw, rkv, ea, knorm, b, S, h, d, ci * CHUNK_L + (tb + 1) * TB, lane);
      scan_block_qm(SQ, SM, st, lane);
    }
    float* qo = Qb + ((size_t)bhd * NC + ci) * 4096 + lane * 64;
    float* mo = Mb + ((size_t)bhd * NC + ci) * 4096 + lane * 64;
#pragma unroll
    for (int q = 0; q < 16; ++q) {
      *(float4*)(qo + 4 * q) = make_float4(SQ[2 * q].x, SQ[2 * q].y, SQ[2 * q + 1].x, SQ[2 * q + 1].y);
      *(float4*)(mo + 4 * q) = make_float4(SM[2 * q].x, SM[2 * q].y, SM[2 * q + 1].x, SM[2 * q + 1].y);
    }
  }
}

__device__ __forceinline__ void ph_scan_pass2(int g_wv, const float* __restrict__ Qb, const float* __restrict__ Mb, float* __restrict__ Sib, int B, int S, char* smem) {
  const int NC = S / CHUNK_L;
  if (NC <= 1) return;
  float* sS = (float*)smem;
  float* sM = sS + 64 * 65;
  const int tid = tid_opaque(), v = (tid >> 2) & 63, q = tid & 3;
  const bool act = tid < 256;
  for (int bhd = blockIdx.x; bhd < B * 16; bhd += gridDim.x) {
    float cur[16];
#pragma unroll
    for (int i = 0; i < 16; ++i) cur[i] = 0.f;
    for (int c = 0; c < NC; ++c) {
      if (act) {
        float* so = Sib + ((size_t)bhd * NC + c) * 4096 + v * 64 + q * 16;
#pragma unroll
        for (int i = 0; i < 4; ++i) *(float4*)(so + 4 * i) = make_float4(cur[4 * i], cur[4 * i + 1], cur[4 * i + 2], cur[4 * i + 3]);
      }
      if (c == NC - 1) break;
      __syncthreads();
      if (act) {
#pragma unroll
        for (int i = 0; i < 16; ++i) sS[v * 65 + q * 16 + i] = cur[i];
        const float* mp = Mb + ((size_t)bhd * NC + c) * 4096;
#pragma unroll
        for (int i = 0; i < 4; ++i) *(float4*)(sM + (tid + 256 * i) * 4) = *(const float4*)(mp + (tid + 256 * i) * 4);
      }
      __syncthreads();
      if (act) {
        const float* qp = Qb + ((size_t)bhd * NC + c) * 4096 + v * 64 + q * 16;
        float nw[16];
#pragma unroll
        for (int i = 0; i < 4; ++i) { float4 t4 = *(const float4*)(qp + 4 * i); nw[4 * i] = t4.x; nw[4 * i + 1] = t4.y; nw[4 * i + 2] = t4.z; nw[4 * i + 3] = t4.w; }
#pragma unroll 4
        for (int j = 0; j < 64; ++j) {
          float sv = sS[v * 65 + j];
#pragma unroll
          for (int i = 0; i < 4; ++i) {
            float4 m4 = *(const float4*)(sM + j * 64 + q * 16 + 4 * i);
            nw[4 * i] += sv * m4.x; nw[4 * i + 1] += sv * m4.y; nw[4 * i + 2] += sv * m4.z; nw[4 * i + 3] += sv * m4.w;
          }
        }
#pragma unroll
        for (int i = 0; i < 16; ++i) cur[i] = nw[i];
      }
    }
    __syncthreads();
  }
}

__device__ __forceinline__ void ph_scan_pass3(int g_wv, const bf16_t* __restrict__ rkv, const bf16_t* __restrict__ ea, const float* __restrict__ knorm, const float* __restrict__ k_k, const float* __restrict__ k_a,
                              const float* __restrict__ Sib, bf16_t* __restrict__ yp, int B, int S, char* smem) {
  const int NC = S / CHUNK_L;
  const int lane = tid_opaque() & 63, wv = __builtin_amdgcn_readfirstlane(tid_opaque() >> 6);
  float* st = (float*)smem + wv * ((TB + 1) * 384);
  const int nunits = B * 16 * NC;
  for (int u = wv * gridDim.x + blockIdx.x; u < nunits; u += NW * gridDim.x) {
    int ci = u & (NC - 1), bhd = u >> (31 - __clz(NC));
    int d = bhd & 1, h = (bhd >> 1) & 7, b = bhd >> 4;
    float kkp = k_k[h * 64 + lane], kap = k_a[h * 64 + lane];
    v2f S2[32];
    if (NC > 1) {
      const float* si = Sib + ((size_t)bhd * NC + ci) * 4096 + lane * 64;
#pragma unroll
      for (int q = 0; q < 16; ++q) { float4 t4 = *(const float4*)(si + 4 * q); S2[2 * q] = (v2f){t4.x, t4.y}; S2[2 * q + 1] = (v2f){t4.z, t4.w}; }
    } else {
#pragma unroll
      for (int k = 0; k < 32; ++k) S2[k] = (v2f){0.f, 0.f};
    }
    ScanRaw raw;
    scan_load(raw, rkv, ea, knorm, b, S, h, d, ci * CHUNK_L, lane);
    for (int tb = 0; tb < CHUNK_L / TB; ++tb) {
      int tau0 = ci * CHUNK_L + tb * TB;
      scan_stage(st, raw, kkp, kap, lane);
      if (tb + 1 < CHUNK_L / TB) scan_load(raw, rkv, ea, knorm, b, S, h, d, tau0 + TB, lane);
      int tt0 = (d == 0) ? tau0 : (S - 1 - tau0);
      bf16_t* yo = yp + ((size_t)d * TG + (size_t)b * S + tt0) * RW + h * 64 + lane;
      scan_block<true>(S2, st, 1.0f, lane, yo, (d == 0) ? (long)RW : -(long)RW);
    }
  }
}

__device__ __forceinline__ float red8(float v) { v += __shfl_xor(v, 1, 64); v += __shfl_xor(v, 2, 64); v += __shfl_xor(v, 4, 64); return v; }
__device__ __forceinline__ void ph_rwkv_post(int g_wv, const bf16_t* __restrict__ yp, const bf16_t* __restrict__ rkv, const bf16_t* __restrict__ ea, const bf16_t* __restrict__ gb,
                             const float* __restrict__ k_a, const float* __restrict__ r_k, const float* __restrict__ ln_g, const float* __restrict__ ln_b,
                             bf16_t* __restrict__ yab) {
  const int lane = tid_opaque() & 63, wv = __builtin_amdgcn_readfirstlane(tid_opaque() >> 6);
  const int c = (lane >> 3) * 64 + (lane & 7) * 8;
  float ka[8], rk[8], lg[8], lb[8];
  {
    float4 t0 = *(const float4*)(k_a + c), t1 = *(const float4*)(k_a + c + 4); ka[0] = t0.x; ka[1] = t0.y; ka[2] = t0.z; ka[3] = t0.w; ka[4] = t1.x; ka[5] = t1.y; ka[6] = t1.z; ka[7] = t1.w;
    t0 = *(const float4*)(r_k + c); t1 = *(const float4*)(r_k + c + 4); rk[0] = t0.x; rk[1] = t0.y; rk[2] = t0.z; rk[3] = t0.w; rk[4] = t1.x; rk[5] = t1.y; rk[6] = t1.z; rk[7] = t1.w;
    t0 = *(const float4*)(ln_g + c); t1 = *(const float4*)(ln_g + c + 4); lg[0] = t0.x; lg[1] = t0.y; lg[2] = t0.z; lg[3] = t0.w; lg[4] = t1.x; lg[5] = t1.y; lg[6] = t1.z; lg[7] = t1.w;
    t0 = *(const float4*)(ln_b + c); t1 = *(const float4*)(ln_b + c + 4); lb[0] = t0.x; lb[1] = t0.y; lb[2] = t0.z; lb[3] = t0.w; lb[4] = t1.x; lb[5] = t1.y; lb[6] = t1.z; lb[7] = t1.w;
  }
  for (int t = blockIdx.x * NW + wv; t < TG; t += gridDim.x * NW) {
    const uint4 uy0 = *(const uint4*)(yp + (size_t)t * RW + c), uy1 = *(const uint4*)(yp + ((size_t)TG + t) * RW + c);
    const uint4 ur = *(const uint4*)(rkv + (size_t)t * 1536 + c), uk = *(const uint4*)(rkv + (size_t)t * 1536 + 512 + c), uv = *(const uint4*)(rkv + (size_t)t * 1536 + 1024 + c);
    const uint4 ua0 = *(const uint4*)(ea + (size_t)t * 2048 + 1024 + c), ua1 = *(const uint4*)(ea + (size_t)t * 2048 + 1536 + c);
    const uint4 ug = *(const uint4*)(gb + (size_t)t * RW + c);
    float y0[8], y1[8], r[8], k[8], v[8], a0[8], a1[8], g[8];
    unpack8(uy0, y0); unpack8(uy1, y1); unpack8(ur, r); unpack8(uk, k); unpack8(uv, v); unpack8(ua0, a0); unpack8(ua1, a1); unpack8(ug, g);
    float y[8], sy = 0.f, sb = 0.f;
#pragma unroll
    for (int i = 0; i < 8; ++i) {
      y[i] = y0[i] + y1[i]; sy += y[i];
      const float kd = k[i] * (2.0f + (a0[i] + a1[i] - 2.0f) * ka[i]);
      sb += r[i] * kd * rk[i];
    }
    const float mean = red8(sy) * (1.0f / 64.0f);
    const float bon = red8(sb);
    float sv = 0.f;
#pragma unroll
    for (int i = 0; i < 8; ++i) { y[i] -= mean; sv += y[i] * y[i]; }
    const float rstd = rsqrtf(red8(sv) * (1.0f / 64.0f) + 64e-5f);
    float o[8];
#pragma unroll
    for (int i = 0; i < 8; ++i) o[i] = (y[i] * rstd * lg[i] + lb[i] + bon * v[i]) * g[i];
    *(uint4*)(yab + (size_t)t * AB_OUT + c) = make_uint4(pack2(o[0], o[1]), pack2(o[2], o[3]), pack2(o[4], o[5]), pack2(o[6], o[7]));
  }
}

__device__ __forceinline__ void ph_pool(int g_wv, const bf16_t* __restrict__ u, bf16_t* __restrict__ dd, int S) {
  const int total = (TG / 4) * 128;
  for (int e = blockIdx.x * NT + tid_opaque(); e < total; e += gridDim.x * NT) {
    const int t0 = (e >> 7) * 4, c = (e & 127) * 8;
    const int s0 = t0 & (S - 1);
    const int g = c >> 8, rad = 1 << g;
    const int lo = (s0 - rad < 0) ? 0 : s0 - rad;
    const int hi = (s0 + 3 + rad + 1 > S) ? S : s0 + 3 + rad + 1;
    float acc[4][8];
    float ctr[4][8];
#pragma unroll
    for (int j = 0; j < 4; ++j)
#pragma unroll
      for (int i = 0; i < 8; ++i) { acc[j][i] = 0.f; ctr[j][i] = 0.f; }
    const bf16_t* base = u + (size_t)(t0 - s0) * DM + c;
    for (int sp = lo; sp < hi; ++sp) {
      float f[8];
      unpack8(*(const uint4*)(base + (size_t)sp * DM), f);
#pragma unroll
      for (int j = 0; j < 4; ++j) {
        const int dlt = sp - (s0 + j);
        const float in = (dlt >= -rad && dlt <= rad) ? 1.f : 0.f, me = (dlt == 0) ? 1.f : 0.f;
#pragma unroll
        for (int i = 0; i < 8; ++i) { acc[j][i] += in * f[i]; ctr[j][i] += me * f[i]; }
      }
    }
#pragma unroll
    for (int j = 0; j < 4; ++j) {
      const int s = s0 + j;
      const int l2 = (s - rad < 0) ? 0 : s - rad, h2 = (s + rad + 1 > S) ? S : s + rad + 1;
      const float inv = 1.0f / (float)(h2 - l2);
      uint4 o;
      o.x = pack2(acc[j][0] * inv - ctr[j][0], acc[j][1] * inv - ctr[j][1]);
      o.y = pack2(acc[j][2] * inv - ctr[j][2], acc[j][3] * inv - ctr[j][3]);
      o.z = pack2(acc[j][4] * inv - ctr[j][4], acc[j][5] * inv - ctr[j][5]);
      o.w = pack2(acc[j][6] * inv - ctr[j][6], acc[j][7] * inv - ctr[j][7]);
      *(uint4*)(dd + (size_t)(t0 + j) * DM + c) = o;
    }
  }
}

#define XB_TMO      128
#define XB_XCNT(j)  (256  + 64 * (j))
#define XB_XSUB(j)  (1280 + 64 * (j))
#define XB_XGEN(j)  (2304 + 64 * (j))
#define XB_TOP      3328
#define XB_TOPGEN   3392
#define XCD_BAR_WORDS 3456
#define XB_SPIN_CAP (1u << 24)
__device__ __forceinline__ unsigned xb_ld(unsigned* p)              { return __hip_atomic_load(p, __ATOMIC_RELAXED, __HIP_MEMORY_SCOPE_AGENT); }
__device__ __forceinline__ unsigned xb_add(unsigned* p, unsigned v) { return __hip_atomic_fetch_add(p, v, __ATOMIC_RELAXED, __HIP_MEMORY_SCOPE_AGENT); }
__device__ __forceinline__ unsigned xb_xcc_id() { return (unsigned)__builtin_amdgcn_s_getreg((3 << 11) | 20) & 0xFu; }
#define XB_SPIN(cond, bar) do { unsigned _sp = 0; while (cond) { __builtin_amdgcn_s_sleep(1); \
    if ((++_sp & 255u) == 0u) { if (xb_ld(&(bar)[XB_TMO])) break; if (_sp > XB_SPIN_CAP) { atomicAdd(&(bar)[XB_TMO], 1u); break; } } } } while (0)
struct XcdBarrier { unsigned* bar; unsigned x; volatile __attribute__((address_space(3))) unsigned* st; };
__device__ __forceinline__ XcdBarrier xcd_barrier_post(int g_wv, unsigned* bar, volatile __attribute__((address_space(3))) unsigned* st) {
  XcdBarrier b; b.bar = bar; b.x = xb_xcc_id(); b.st = st;
  if (tid_opaque() == 0) (void)xb_add(&bar[XB_XCNT(b.x)], 1u);
  return b;
}
__device__ __forceinline__ void xcd_barrier_complete(unsigned* bar, unsigned x, unsigned& nloc, unsigned& nx) {
  const unsigned G = gridDim.x * gridDim.y * gridDim.z;
  unsigned sum, cnt, mine, sp = 0u;
  for (;;) {
    sum = 0u; cnt = 0u; mine = 0u;
#pragma unroll
    for (unsigned j = 0; j < 16; ++j) { const unsigned c = xb_ld(&bar[XB_XCNT(j)]); sum += c; cnt += (c > 0u) ? 1u : 0u; mine = (j == x) ? c : mine; }
    if (sum == G) break;
    __builtin_amdgcn_s_sleep(1);
    if ((++sp & 255u) == 0u) { if (xb_ld(&bar[XB_TMO])) break; if (sp > XB_SPIN_CAP) { atomicAdd(&bar[XB_TMO], 1u); break; } }
  }
  nloc = mine > 0u ? mine : 1u; nx = cnt > 0u ? cnt : 1u;
}
__device__ __forceinline__ void xcd_barrier(int g_wv, const XcdBarrier& b) {
  asm volatile("s_waitcnt vmcnt(0)" ::: "memory");
  __syncthreads();
  if (tid_opaque() == 0) {
    unsigned* bar = b.bar;
    __builtin_amdgcn_s_waitcnt(0);
    unsigned nloc = b.st[0], nx = b.st[1];
    if (nloc == 0u) { xcd_barrier_complete(bar, b.x, nloc, nx); b.st[0] = nloc; b.st[1] = nx; }
    const unsigned old = xb_add(&bar[XB_XSUB(b.x)], 1u);
    const unsigned gen = old / nloc;
    if (old + 1u == (gen + 1u) * nloc) {
      __builtin_amdgcn_fence(__ATOMIC_RELEASE, "agent");
      asm volatile("s_waitcnt vmcnt(0)" ::: "memory");
      const unsigned og = xb_add(&bar[XB_TOP], 1u);
      const unsigned tg = og / nx;
      if (og + 1u == (tg + 1u) * nx) xb_add(&bar[XB_TOPGEN], 1u);
      else XB_SPIN(xb_ld(&bar[XB_TOPGEN]) == tg, bar);
      __builtin_amdgcn_fence(__ATOMIC_ACQUIRE, "agent");
      xb_add(&bar[XB_XGEN(b.x)], 1u);
      asm volatile("s_waitcnt vmcnt(0)" ::: "memory");
    } else {
      XB_SPIN(xb_ld(&bar[XB_XGEN(b.x)]) == gen, bar);
      __builtin_amdgcn_fence(__ATOMIC_ACQUIRE, "agent");
      asm volatile("s_waitcnt vmcnt(0)" ::: "memory");
    }
  }
  __syncthreads();
}

__global__ void __launch_bounds__(512) mega(Params P) {
  cg::grid_group grid = cg::this_grid();
  const int g_wv = __builtin_amdgcn_readfirstlane((int)(threadIdx.x >> 6));
  extern __shared__ __attribute__((aligned(16))) char smem[];
  __shared__ uint4 xb_words;
  if (tid_opaque() == 0) xb_words = make_uint4(0u, 0u, 0u, 0u);
  __syncthreads();
  XcdBarrier xb = xcd_barrier_post(g_wv, (unsigned*)(P.ws + OFF_BAR), (volatile __attribute__((address_space(3))) unsigned*)&xb_words);
  char* ws = P.ws;
  bf16_t* Wb = (bf16_t*)(ws + OFF_W);
  float2* rot = (float2*)(ws + OFF_ROT);

  for (int j = 0; j < 2; ++j) {
    bf16_t* we = Wb + WOFF_EVEN + (size_t)j * W_EVEN;
    transpose_w(g_wv, P.in[4] + (size_t)j * DM * AB_IN, DM, AB_IN, we, DM, 0, smem);
    for (int e = blockIdx.x * NT + tid_opaque(); e < (AB_PAD - AB_IN) * DM / 8; e += gridDim.x * NT) { unsigned z = 0; asm volatile("" : "+v"(z)); *(uint4*)(we + (size_t)AB_IN * DM + (size_t)e * 8) = make_uint4(z, z, z, z); }
    transpose_w(g_wv, P.in[5] + (size_t)j * AB_OUT * DM, AB_OUT, DM, we + W_AB, AB_OUT, 0, smem);
    build_lora(g_wv, P.in[8] + (size_t)j * 2 * 64 * RW, P.in[10] + (size_t)j * 2 * 64 * RW, P.in[11] + (size_t)j * 128 * RW, we + W_AB + W_ABO);
    bf16_t* wo = Wb + WOFF_ODD + (size_t)j * W_ODD;
    transpose_w(g_wv, P.in[17] + (size_t)j * DM * DM, DM, DM, wo, DM, 0, smem);
    for (int g = 0; g < 4; ++g) transpose_w(g_wv, P.in[18] + ((size_t)j * 4 + g) * 256 * 256, 256, 256, wo + W_CIN + (size_t)g * 256 * 256, 256, 0, smem);
    transpose_w(g_wv, P.in[20] + (size_t)j * DM * DM, DM, DM, wo + W_CIN + W_GRP, DM, 0, smem);
  }
  for (int i = 0; i < 4; ++i) {
    bf16_t* wl = Wb + WOFF_LAYER + (size_t)i * W_LAYER;
    transpose_w(g_wv, P.in[25] + (size_t)i * DM * UP, DM, UP, wl, DM, 1, smem);
    transpose_w(g_wv, P.in[28] + (size_t)i * DFF * DM, DFF, DM, wl + W_UP, DFF, 0, smem);
    transpose_w(g_wv, P.in[30] + (size_t)i * DM * DM, DM, DM, wl + W_UP + W_DOWN, DM, 0, smem);
    transpose_w(g_wv, P.in[29] + (size_t)i * PLE * DM, PLE, DM, wl + W_UP + W_DOWN + W_GATE, PLE, 0, smem);
  }
  build_rotary(g_wv, rot);
  grid.sync();

  bf16_t* hb = (bf16_t*)(ws + OFF_A + HB_HALO);
  bf16_t* z1 = (bf16_t*)(ws + OFF_Z1);
  bf16_t* z2 = (bf16_t*)(ws + OFF_Z2);
  bf16_t* yab = (bf16_t*)(ws + OFF_Y);
  bf16_t* pb = (bf16_t*)(ws + OFF_Y);
  bf16_t* rkv = (bf16_t*)(ws + OFF_RKV);
  float* opart = (float*)(ws + OFF_RKV);
  float* lsep = (float*)(ws + OFF_LSE);
  bf16_t* Lb = (bf16_t*)(ws + OFF_L);
  bf16_t* gbuf = (bf16_t*)(ws + OFF_G);
  bf16_t* ea = (bf16_t*)(ws + OFF_Z2);
  bf16_t* ypb = (bf16_t*)(ws + OFF_YP);
  float* Qb = (float*)(ws + OFF_SQ);
  float* Mb = (float*)(ws + OFF_SM);
  float* Sib = (float*)(ws + OFF_SI);
  bf16_t* act = (bf16_t*)(ws + OFF_Z1);
  bf16_t* ub = (bf16_t*)(ws + OFF_Z1);
  bf16_t* db = (bf16_t*)(ws + OFF_Z2);
  bf16_t* ygb = (bf16_t*)(ws + OFF_RKV);
  bf16_t* hb2 = (bf16_t*)(ws + OFF_RKV);
  float* knb = (float*)(ws + OFF_KN);
  bf16_t* edgeb = (bf16_t*)(ws + OFF_EDGE);
  float* ps0 = (float*)(ws + OFF_PS);
  float* ps1 = ps0 + (size_t)TG * 16;
  float* ps2 = ps1 + (size_t)TG * 16;

#ifndef PROBE_A
#define PROBE_A -1
#endif
#ifndef PROBE_B
#define PROBE_B -1
#endif
  unsigned long long accA = 0, accB = 0;
#define PH(cat, ...)                                                                   \
  {                                                                                    \
    unsigned long long t0_ = 0;                                                        \
    if ((cat) == PROBE_A || (cat) == PROBE_B || (PROBE_A == 100 && (cat) >= 10)) t0_ = wall_clock64();                    \
    __VA_ARGS__;                                                                       \
    xcd_barrier(g_wv, xb);                                                             \
    if (PROBE_A == 99) xcd_barrier(g_wv, xb);                                          \
    if ((cat) == PROBE_A || (PROBE_A == 100 && (cat) >= 10)) accA += wall_clock64() - t0_;                                \
    if ((cat) == PROBE_B) accB += wall_clock64() - t0_;                                \
  }
  for (int grp = 0; grp < 2; ++grp) {
    const int B = grp ? 16 : 2, S = grp ? 2048 : 16384;
    const float* xin = P.in[grp];
    const float* pin = P.in[2 + grp];
    float* xo = P.out + (size_t)grp * TG * DM;
    for (int layer = 0; layer < DEPTH; ++layer) {
      const int j = layer >> 1;
      const float* xcur = layer ? xo : xin;
      const bf16_t* wl = Wb + WOFF_LAYER + (size_t)layer * W_LAYER;
      const bf16_t* amix = layer ? hb2 : hb;
      const float* psmix = layer ? ps2 : nullptr;
      if (layer == 0) PH(3, ph_rmsnorm(g_wv, xcur, P.in[21] + layer * DM, hb, TG, nullptr, nullptr));
      if ((layer & 1) == 0) {
        const bf16_t* we = Wb + WOFF_EVEN + (size_t)j * W_EVEN;
        PH(10, ph_gemm_ab(g_wv, amix, we, z1, z2, psmix, smem));
        PH(2, ph_attention(g_wv, z2, rot, opart, lsep, B, S, smem));
        PH(2, ph_attn_combine(g_wv, opart, lsep, yab));
        PH(3, ph_rwkv_prep(g_wv, z1, P.in[6] + j * RWKV_IN, rkv, Lb, S, P.in[12] + j * RW, knb));
        PH(11, ph_gemm_lora(g_wv, Lb, we + W_AB + W_ABO, P.in[7] + j * 1024, P.in[9] + j * 1024, ea, gbuf, smem));
        PH(1, ph_scan_pass1(g_wv, rkv, ea, knb, P.in[12] + j * RW, P.in[13] + j * RW, Qb, Mb, B, S, smem));
        PH(1, ph_scan_pass2(g_wv, Qb, Mb, Sib, B, S, smem));
        PH(1, ph_scan_pass3(g_wv, rkv, ea, knb, P.in[12] + j * RW, P.in[13] + j * RW, Sib, ypb, B, S, smem));
        PH(3, ph_rwkv_post(g_wv, ypb, rkv, ea, gbuf, P.in[13] + j * RW, P.in[14] + j * RW, P.in[15] + j * RW, P.in[16] + j * RW, yab));
        PH(12, zero_hb_halo(g_wv, hb, TG); ph_gemm_res(g_wv, yab, AB_OUT, we + W_AB, xcur, xo, P.in[22] + layer * DM, hb, ps0, smem));
      } else {
        const bf16_t* wo = Wb + WOFF_ODD + (size_t)j * W_ODD;
        PH(16, ph_gemm_bf16(g_wv, amix, DM, DM, 0, wo, nullptr, ub, psmix, smem));
        PH(3, ph_pool(g_wv, ub, db, S));
        PH(16, ph_gemm_bf16(g_wv, db, DM, 256, 1, wo + W_CIN, P.in[19] + j * DM, ygb, nullptr, smem));
        PH(16, zero_hb_halo(g_wv, hb, TG); ph_gemm_res(g_wv, ygb, DM, wo + W_CIN + W_GRP, xcur, xo, P.in[22] + layer * DM, hb, ps0, smem));
      }
      PH(13, ph_ffn_up(g_wv, hb, wl, P.in[26] + (size_t)layer * 3 * UP, P.in[27] + (size_t)layer * UP, act, B, S, ps0, pin + (size_t)layer * TG * PLE, pb, edgeb, smem));
      PH(3, ph_ffn_edges(g_wv, edgeb, P.in[26] + (size_t)layer * 3 * UP, P.in[27] + (size_t)layer * UP, act, S));
      PH(14, ph_gemm_res(g_wv, act, DFF, wl + W_UP, xo, xo, P.in[23] + layer * DM, hb, ps1, smem));
      PH(15, ph_ple(g_wv, hb, wl + W_UP + W_DOWN, P.in[31] + layer * DM, pb, wl + W_UP + W_DOWN + W_GATE, z1, xo, ps1,
                    P.in[21] + ((layer + 1 < DEPTH) ? (layer + 1) : layer) * DM, (layer + 1 < DEPTH) ? hb2 : nullptr, ps2, smem));
    }
    ph_final_norm(g_wv, xo, P.in[24], TG);
  }
#if PROBE_A >= 0
  if (blockIdx.x == 0 && tid_opaque() == 0) {
    unsigned long long wait = accA + accB;
    unsigned long long ts = wall_clock64();
    while (wall_clock64() - ts < wait) __builtin_amdgcn_s_sleep(32);
  }
#endif
}

extern "C" void kernel_launch(void* const* d_in, const int* in_sizes, int n_in, void* d_out, int out_size, void* d_ws, size_t ws_size, hipStream_t stream) {
  static int grid_blocks = 0;
  if (!grid_blocks) {
    int dev = 0, cus = 0, per_cu = 0;
    (void)hipGetDevice(&dev);
    (void)hipDeviceGetAttribute(&cus, hipDeviceAttributeMultiprocessorCount, dev);
    (void)hipFuncSetAttribute((const void*)mega, hipFuncAttributeMaxDynamicSharedMemorySize, SMEM_BYTES);
    (void)hipOccupancyMaxActiveBlocksPerMultiprocessor(&per_cu, (const void*)mega, NT, SMEM_BYTES);
    if (per_cu < 1) per_cu = 1;
    if (per_cu > 1) per_cu = 1;
    grid_blocks = cus * per_cu;
    if (ws_size < WS_NEED) fprintf(stderr, "kernel_launch: workspace too small: %zu < %zu\n", ws_size, (size_t)WS_NEED);
  }
  if (ws_size < WS_NEED || n_in != 32) return;
  Params p{};
  for (int i = 0; i < 32; ++i) p.in[i] = (const float*)d_in[i];
  p.out = (float*)d_out;
  p.ws = (char*)d_ws;
  (void)hipMemsetAsync((char*)d_ws + OFF_BAR, 0, SZ_BAR, stream);
  void* args[] = {&p};
  hipError_t e = hipLaunchCooperativeKernel((const void*)mega, dim3(grid_blocks), dim3(NT), args, SMEM_BYTES, stream);
  if (e != hipSuccess) fprintf(stderr, "cooperative launch failed: %s (grid %d)\n", hipGetErrorString(e), grid_blocks);
}
```
